# Optimizing an MI355X kernel written in HIP

```python
import jax, jax.numpy as jnp
from jax import lax
import numpy as np

D_MODEL = 2048
BATCH = 4
SEQ = 2048
DEPTH = 1

CHUNK = 64
MIX_WIDTH = D_MODEL
ATT_WIDTH = MIX_WIDTH // 2
HG_WIDTH = MIX_WIDTH - ATT_WIDTH
ATT_HEAD_DIM = 128
ATT_HEADS = ATT_WIDTH // ATT_HEAD_DIM
ATT_LEFT_CHUNKS = 8
ATT_BAND = ATT_LEFT_CHUNKS + 1
MAX_REL = 128
HG_EXPAND = 128
HG_HEADS = HG_WIDTH // HG_EXPAND
HG_KDIM = HG_EXPAND
HG_FDIM = HG_HEADS * HG_KDIM
HG_VDIM = HG_WIDTH // HG_HEADS
IN_SPLITS = (ATT_WIDTH, ATT_WIDTH, ATT_WIDTH, ATT_WIDTH, HG_FDIM, HG_FDIM, HG_WIDTH, HG_WIDTH)
IN_COLS = sum(IN_SPLITS)
EPS = 1e-6

kernel_name = "hymba_chunkattn_hgrn2_adaln_block"


def _rms(x, g):
    xf = x.astype(jnp.float32)
    y = xf * lax.rsqrt(jnp.mean(xf * xf, axis=-1, keepdims=True) + EPS)
    return (y * g.astype(jnp.float32)).astype(x.dtype)


def _chunk_attention(q, k, v, q_g, k_g, rel_bias):
    B, T, H, dh = q.shape
    N = T // CHUNK
    q = _rms(q, q_g).reshape(B, N, CHUNK, H, dh)
    k = _rms(k, k_g).reshape(B, N, CHUNK, H, dh)
    v = v.reshape(B, N, CHUNK, H, dh)
    pad = ((0, 0), (ATT_LEFT_CHUNKS, 0), (0, 0), (0, 0), (0, 0))
    kp = jnp.pad(k, pad)
    vp = jnp.pad(v, pad)
    band_idx = jnp.arange(N)[:, None] + jnp.arange(ATT_BAND)[None, :]
    kb = kp[:, band_idx].reshape(B, N, ATT_BAND * CHUNK, H, dh)
    vb = vp[:, band_idx].reshape(B, N, ATT_BAND * CHUNK, H, dh)
    scores = jnp.einsum('bnqhd,bnkhd->bnhqk', q, kb).astype(jnp.float32) * (dh ** -0.5)
    qi = jnp.arange(CHUNK)
    kj = jnp.arange(ATT_BAND * CHUNK)
    dist = ATT_LEFT_CHUNKS * CHUNK + qi[:, None] - kj[None, :]
    bias_idx = jnp.clip(dist, -MAX_REL, MAX_REL) + MAX_REL
    bias = rel_bias.astype(jnp.float32)[:, bias_idx]
    valid = (jnp.arange(N)[:, None] + kj[None, :] // CHUNK) >= ATT_LEFT_CHUNKS
    scores = jnp.where(valid[None, :, None, None, :], scores + bias[None, None], -jnp.inf)
    p = jax.nn.softmax(scores, axis=-1).astype(v.dtype)
    out = jnp.einsum('bnhqk,bnkhd->bnqhd', p, vb)
    return out.reshape(B, T, H * dh)


def _hgrn2(q_raw, f_raw, i, lb, o_g):
    B, T, _ = q_raw.shape
    N = T // CHUNK
    out_dtype = i.dtype
    f32 = jnp.float32
    q = jax.nn.silu(q_raw.astype(f32))
    fr = f_raw.astype(f32)
    lb = lb.astype(f32)
    logf = jnp.log(lb + (1.0 - lb) * jax.nn.sigmoid(fr))
    k = (1.0 - lb) * jax.nn.sigmoid(-fr)
    v = i.astype(f32)

    def to_chunks(a, d):
        return a.reshape(B, N, CHUNK, HG_HEADS, d).transpose(1, 0, 3, 2, 4)

    qc, kc, lc = to_chunks(q, HG_KDIM), to_chunks(k, HG_KDIM), to_chunks(logf, HG_KDIM)
    vc = to_chunks(v, HG_VDIM)
    tril = jnp.arange(CHUNK)[:, None] >= jnp.arange(CHUNK)[None, :]

    def step(S, xs):
        qn, kn, vn, ln = xs
        b = jnp.cumsum(ln, axis=2)
        b_last = b[:, :, -1]
        inter = jnp.einsum('bhcd,bhde->bhce', qn * jnp.exp(b), S)
        diff = b[:, :, :, None, :] - b[:, :, None, :, :]
        decay = jnp.exp(jnp.where(tril[None, None, :, :, None], diff, -jnp.inf))
        A = jnp.einsum('bhtd,bhtsd,bhsd->bhts', qn, decay, kn)
        intra = jnp.einsum('bhts,bhse->bhte', A, vn)
        k_dec = kn * jnp.exp(b_last[:, :, None, :] - b)
        S_new = jnp.exp(b_last)[..., None] * S + jnp.einsum('bhsd,bhse->bhde', k_dec, vn)
        return S_new, inter + intra

    S0 = jnp.zeros((B, HG_HEADS, HG_KDIM, HG_VDIM), f32)
    _, o = lax.scan(step, S0, (qc, kc, vc, lc))
    o = o.transpose(1, 0, 3, 2, 4).reshape(B, T, HG_HEADS, HG_VDIM)
    o = _rms(o, o_g)
    return o.reshape(B, T, HG_WIDTH).astype(out_dtype)


def setup_inputs(seed: int = 0) -> dict:
    key = jax.random.key(seed)
    ks = jax.random.split(key, 16)
    D = D_MODEL
    f32 = jnp.float32
    nrm = lambda k, s: jax.random.normal(k, s, f32)
    return {
        "x": nrm(ks[0], (BATCH, SEQ, D)),
        "c": nrm(ks[1], (BATCH, D)),
        "norm_g": 1.0 + 0.1 * nrm(ks[2], (DEPTH, D)),
        "w_ada": nrm(ks[3], (DEPTH, D, 3 * D)) * D ** -0.5,
        "b_ada": 0.01 * nrm(ks[4], (DEPTH, 3 * D)),
        "w_in": nrm(ks[5], (DEPTH, D, IN_COLS)) * D ** -0.5,
        "q_norm_g": 1.0 + 0.1 * nrm(ks[6], (DEPTH, ATT_HEAD_DIM)),
        "k_norm_g": 1.0 + 0.1 * nrm(ks[7], (DEPTH, ATT_HEAD_DIM)),
        "rel_bias": 0.5 * nrm(ks[8], (DEPTH, ATT_HEADS, 2 * MAX_REL + 1)),
        "lower_bounds": nrm(ks[9], (DEPTH + 1, HG_FDIM)),
        "hg_norm_g": 1.0 + 0.1 * nrm(ks[10], (DEPTH, HG_VDIM)),
        "w_out": nrm(ks[11], (DEPTH, MIX_WIDTH, D)) * MIX_WIDTH ** -0.5,
    }


def reference(x, c, norm_g, w_ada, b_ada, w_in, q_norm_g, k_norm_g, rel_bias,
              lower_bounds, hg_norm_g, w_out):
    B, T, D = x.shape
    lbs = jnp.cumsum(jax.nn.softmax(lower_bounds.astype(jnp.float32), axis=0), axis=0)
    offsets = np.cumsum(IN_SPLITS)[:-1].tolist()
    c_act = jax.nn.silu(c)
    for l in range(DEPTH):
        mod = c_act @ w_ada[l] + b_ada[l]
        shift, scale, gate = jnp.split(mod, 3, axis=-1)
        h = _rms(x, norm_g[l]) * (1.0 + scale[:, None, :]) + shift[:, None, :]
        proj = h @ w_in[l]
        a_q, a_k, a_v, a_z, g_q, g_f, g_i, g_z = jnp.split(proj, offsets, axis=-1)
        hs = (B, T, ATT_HEADS, ATT_HEAD_DIM)
        att = _chunk_attention(a_q.reshape(hs), a_k.reshape(hs), a_v.reshape(hs),
                               q_norm_g[l], k_norm_g[l], rel_bias[l])
        att = att * jax.nn.silu(a_z)
        hg = _hgrn2(g_q, g_f, g_i, lbs[l], hg_norm_g[l]) * jax.nn.silu(g_z)
        y = jnp.concatenate([att, hg], axis=-1) @ w_out[l]
        x = x + gate[:, None, :] * y
    return x
```

```cpp
#include <hip/hip_runtime.h>
#include <cstdio>
#include <cstdint>

#ifndef MK_N_LAUNCHES
#define MK_N_LAUNCHES 1
#endif
namespace pg8 {
#define PG8_LAS __attribute__((address_space(3)))
typedef unsigned short bf16_t;
typedef short bf16x8 __attribute__((ext_vector_type(8)));
typedef float f32x4 __attribute__((ext_vector_type(4)));
typedef unsigned u32x4 __attribute__((ext_vector_type(4)));
constexpr int BM = 256, BK = 64, HALF = 128, HTB = HALF * BK * 2  , STAGE_BYTES = 8 * HTB, NXCD = 8, WGM = 8;

__host__ __device__ __forceinline__ int lds_byte(int r, int c) { const int st = (r >> 4) * 2 + (c >> 5), rr = r & 15, cc = c & 31, ob = rr * 64 + cc * 2; return st * 1024 + (ob ^ (((ob >> 9) & 1) << 5)); }
__host__ __device__ __forceinline__ void stage_rc(int b, int& R, int& C) { const int st = b / 1024, sb = b % 1024, swz = sb ^ (((sb >> 9) & 1) << 5); R = (st >> 1) * 16 + swz / 64; C = (st & 1) * 32 + (swz % 64) / 2; }
__host__ __device__ __forceinline__ int perm32(int rho) { const int n = rho >> 4, i = rho & 15; return 8 * (i >> 2) + 4 * n + (i & 3); }

struct Unit { int pm, pn; };
struct Gemm { const bf16_t* A; const bf16_t* Bt; int M, N, K; };

struct StaticOrder {
    int nM, nN, nwg, G, c;
    __host__ __device__ void init(int M, int N, int G_, int c_) { nM = M / BM; nN = N / BM; nwg = nM * nN; G = G_; c = c_; }
    __host__ __device__ bool next(int i, Unit& u) const {
        const long L = (long)i * G + c; if (L >= nwg) return false;
        int wgid = (int)L; { const int q = nwg / NXCD, r = nwg % NXCD, xcd = wgid % NXCD, off = wgid / NXCD; wgid = (xcd < r ? xcd * (q + 1) : r * (q + 1) + (xcd - r) * q) + off; }
        const int nig = WGM * nN, gid = wgid / nig, fm = gid * WGM, gsz = (nM - fm) < WGM ? (nM - fm) : WGM;
        u.pm = fm + ((wgid % nig) % gsz); u.pn = (wgid % nig) / gsz; return true;
    }
    __device__ __forceinline__ void a_ready(const Unit&) const {}
    __device__ __forceinline__ void done(const Unit&) const {}
};

__device__ __forceinline__ unsigned cvt_pk_bf16(float lo, float hi) { unsigned r; asm volatile("v_cvt_pk_bf16_f32 %0, %1, %2" : "=v"(r) : "v"(lo), "v"(hi)); return r; }
__device__ __forceinline__ float silu_f(float v) { return v * __builtin_amdgcn_rcpf(1.0f + __builtin_amdgcn_exp2f(-1.4426950408889634f * v)); }
struct EpiProj {
    static constexpr bool PERM = true, AFTER_DRAIN = false;
    bf16_t* O; int ldc;
    __device__ __forceinline__ void operator()(const f32x4 (&acc)[2][2][4][2], const Unit& u, int wr, int wc, int fr, int fq) const {
        const int row0 = u.pm * BM + wr * 64 + fr, col0 = u.pn * BM + wc * 32 + 8 * fq;
        const int grp = u.pn >> 2; const bool act = (grp == 3) || (grp == 4) || (grp == 7);
#pragma unroll
        for (int ai = 0; ai < 2; ++ai)
#pragma unroll
            for (int m = 0; m < 4; ++m) { bf16_t* rowp = O + (size_t)(row0 + ai * HALF + m * 16) * ldc + col0;
#pragma unroll
                for (int bj = 0; bj < 2; ++bj) { f32x4 v0 = acc[ai][bj][m][0], v1 = acc[ai][bj][m][1];
                    if (act) {
#pragma unroll
                        for (int i = 0; i < 4; ++i) { v0[i] = silu_f(v0[i]); v1[i] = silu_f(v1[i]); } }
                    u32x4 w; w.x = cvt_pk_bf16(v0[0], v0[1]); w.y = cvt_pk_bf16(v0[2], v0[3]); w.z = cvt_pk_bf16(v1[0], v1[1]); w.w = cvt_pk_bf16(v1[2], v1[3]);
                    *(u32x4*)(rowp + bj * HALF) = w; } }
    }
};
struct EpiOut {
    static constexpr bool PERM = false, AFTER_DRAIN = false;
    const float* x; float* out; const float* gate;
    __device__ __forceinline__ void operator()(const f32x4 (&acc)[2][2][4][2], const Unit& u, int wr, int wc, int fr, int fq) const {
        const int row0 = u.pm * BM + wr * 64 + fr, col0 = u.pn * BM + wc * 32 + 4 * fq;
        const float* gp = gate + (size_t)(u.pm >> 3) * 6144 + col0;
        f32x4 gv[2][2];
#pragma unroll
        for (int bj = 0; bj < 2; ++bj)
#pragma unroll
            for (int n = 0; n < 2; ++n) gv[bj][n] = *(const f32x4*)(gp + bj * HALF + n * 16);
#pragma unroll
        for (int ai = 0; ai < 2; ++ai)
#pragma unroll
            for (int m = 0; m < 4; ++m) { const size_t off = (size_t)(row0 + ai * HALF + m * 16) * 2048 + col0;
#pragma unroll
                for (int bj = 0; bj < 2; ++bj)
#pragma unroll
                    for (int n = 0; n < 2; ++n) { const f32x4 xv = *(const f32x4*)(x + off + bj * HALF + n * 16);
                        *(f32x4*)(out + off + bj * HALF + n * 16) = xv + gv[bj][n] * acc[ai][bj][m][n]; } }
    }
};

template <class Epi, class Sched, bool ALIGN_EPI = false, bool SP2 = false>
__device__ __forceinline__ void gemm_phase(PG8_LAS unsigned char* lds, const Gemm g, const Sched& S, const Epi& E) {
    const int tid = threadIdx.x, wid = __builtin_amdgcn_readfirstlane(tid >> 6), lane = tid & 63, wr = wid >> 2, wc = wid & 3, fr = lane & 15, fq = lane >> 4;
    const int K = g.K, nt = K / BK;
    unsigned voffA[2], voffB[2];
#pragma unroll
    for (int i = 0; i < 2; ++i) { int R, C; stage_rc(tid * 16 + i * 8192, R, C); const int Rb = Epi::PERM ? ((R & ~31) + perm32(R & 31)) : R;
        voffA[i] = (unsigned)(R * K + C) * 2u; voffB[i] = (unsigned)(Rb * K + C) * 2u; }
    const size_t kstep = (size_t)(BK * 2);
    const size_t hstep = (size_t)HALF * K * 2;
    const size_t tstep = 2 * hstep;
    const unsigned ldsw = (unsigned)wid * 1024u;
    const int aoff = lds_byte(wr * 64 + fr, fq * 8), boff = lds_byte(wc * 32 + fr, fq * 8);
#define PG8_SA(b, h) (((b) * 2 + (h)) * HTB)
#define PG8_SB(b, h) ((4 + (b) * 2 + (h)) * HTB)
#define PG8_STAGE(bufoff, gbase, voff) do { _Pragma("unroll") for (int _i = 0; _i < 2; ++_i) \
        __builtin_amdgcn_global_load_lds((const unsigned*)((const char*)(gbase) + (voff)[_i]), (PG8_LAS unsigned*)(lds + (bufoff) + ldsw + _i * 8192), 16, 0, 0); } while (0)
#define PG8_LDA(dst, b, h) do { _Pragma("unroll") for (int m = 0; m < 4; ++m) _Pragma("unroll") for (int k = 0; k < 2; ++k) dst[m][k] = *(const PG8_LAS bf16x8*)(lds + PG8_SA(b, h) + aoff + m * 2048 + k * 1024); } while (0)
#define PG8_LDB(dst, b, h) do { _Pragma("unroll") for (int n = 0; n < 2; ++n) _Pragma("unroll") for (int k = 0; k < 2; ++k) dst[n][k] = *(const PG8_LAS bf16x8*)(lds + PG8_SB(b, h) + boff + n * 2048 + k * 1024); } while (0)
#define PG8_MMA(ai, bj, At, Bt) do { __builtin_amdgcn_s_setprio(1); _Pragma("unroll") for (int m = 0; m < 4; ++m) _Pragma("unroll") for (int n = 0; n < 2; ++n) _Pragma("unroll") for (int k = 0; k < 2; ++k) \
        acc[ai][bj][m][n] = __builtin_amdgcn_mfma_f32_16x16x32_bf16(Bt[n][k], At[m][k], acc[ai][bj][m][n], 0, 0, 0); __builtin_amdgcn_s_setprio(0); } while (0)
#define PG8_WAIT_V(n) asm volatile("s_waitcnt vmcnt(" #n ")" ::: "memory")
#define PG8_WAIT_L(n) asm volatile("s_waitcnt lgkmcnt(" #n ")" ::: "memory")
#define PG8_BAR __builtin_amdgcn_s_barrier()
#define PG8_SCHED __builtin_amdgcn_sched_barrier(0)
    Unit cur, nxt; int ui = 0;
    if (!S.next(0, cur)) return;
    f32x4 acc[2][2][4][2];
#pragma unroll
    for (int a = 0; a < 2; ++a)
#pragma unroll
        for (int b = 0; b < 2; ++b)
#pragma unroll
            for (int m = 0; m < 4; ++m)
#pragma unroll
                for (int n = 0; n < 2; ++n) acc[a][b][m][n] = (f32x4){0.f, 0.f, 0.f, 0.f};
    bf16x8 At[4][2], B0[2][2], B1[2][2];
    const char* cA = (const char*)g.A + (size_t)cur.pm * tstep; const char* cB = (const char*)g.Bt + (size_t)cur.pn * tstep;
    S.a_ready(cur);
    if constexpr (SP2) {
        PG8_STAGE(PG8_SB(0, 0), cB, voffB); PG8_STAGE(PG8_SB(0, 1), cB + hstep, voffB); PG8_STAGE(PG8_SA(0, 0), cA, voffA); PG8_STAGE(PG8_SA(0, 1), cA + hstep, voffA);
        if (wr == 1) PG8_BAR;
        PG8_WAIT_V(2); PG8_BAR;
        PG8_STAGE(PG8_SB(1, 0), cB + kstep, voffB); PG8_STAGE(PG8_SA(1, 0), cA + kstep, voffA); PG8_STAGE(PG8_SB(1, 1), cB + hstep + kstep, voffB);
        PG8_WAIT_V(6); PG8_BAR;
    } else {
        PG8_STAGE(PG8_SB(0, 0), cB, voffB); PG8_STAGE(PG8_SA(0, 0), cA, voffA); PG8_STAGE(PG8_SB(0, 1), cB + hstep, voffB); PG8_STAGE(PG8_SA(0, 1), cA + hstep, voffA);
        if (wr == 1) PG8_BAR;
        PG8_WAIT_V(4); PG8_BAR;
        PG8_STAGE(PG8_SB(1, 0), cB + kstep, voffB); PG8_STAGE(PG8_SA(1, 0), cA + kstep, voffA); PG8_STAGE(PG8_SB(1, 1), cB + hstep + kstep, voffB);
        PG8_WAIT_V(6); PG8_BAR;
    }
    for (;;) {
        const bool has_next = S.next(ui + 1, nxt);
        const char* nA = has_next ? (const char*)g.A + (size_t)nxt.pm * tstep : cA; const char* nB = has_next ? (const char*)g.Bt + (size_t)nxt.pn * tstep : cB;
        for (int t = 0; t < nt; t += 2) {
            const bool last = (t == nt - 2);
            const char* a1 = cA + (size_t)(t + 1) * kstep;
            const char* a2 = last ? nA : cA + (size_t)(t + 2) * kstep; const char* b2 = last ? nB : cB + (size_t)(t + 2) * kstep;
            const char* a3 = a2 + kstep; const char* b3 = b2 + kstep;
            if (last && has_next) S.a_ready(nxt);
            if constexpr (SP2) {
            PG8_LDB(B0, 0, 0); PG8_LDB(B1, 0, 1); PG8_SCHED; PG8_LDA(At, 0, 0); PG8_STAGE(PG8_SA(1, 1), a1 + hstep, voffA);
            PG8_WAIT_V(8); PG8_WAIT_L(0); PG8_BAR; PG8_MMA(0, 0, At, B0); PG8_MMA(0, 1, At, B1); PG8_BAR; PG8_SCHED;
            PG8_LDA(At, 0, 1); PG8_STAGE(PG8_SB(0, 0), b2, voffB); PG8_STAGE(PG8_SB(0, 1), b2 + hstep, voffB); PG8_STAGE(PG8_SA(0, 0), a2, voffA);
            PG8_WAIT_V(8); PG8_WAIT_L(0); PG8_BAR; PG8_MMA(1, 0, At, B0); PG8_MMA(1, 1, At, B1); PG8_BAR; PG8_SCHED;
            PG8_LDB(B0, 1, 0); PG8_LDB(B1, 1, 1); PG8_SCHED; PG8_LDA(At, 1, 0); PG8_STAGE(PG8_SA(0, 1), a2 + hstep, voffA);
            PG8_WAIT_V(8); PG8_WAIT_L(0); PG8_BAR; PG8_MMA(0, 0, At, B0); PG8_MMA(0, 1, At, B1); PG8_BAR; PG8_SCHED;
            PG8_LDA(At, 1, 1); PG8_STAGE(PG8_SB(1, 0), b3, voffB); PG8_STAGE(PG8_SB(1, 1), b3 + hstep, voffB); PG8_STAGE(PG8_SA(1, 0), a3, voffA);
            PG8_WAIT_V(8); PG8_WAIT_L(0); PG8_BAR; PG8_MMA(1, 0, At, B0); PG8_MMA(1, 1, At, B1); PG8_BAR; PG8_SCHED;
            } else {
            PG8_LDB(B0, 0, 0); PG8_SCHED; PG8_LDA(At, 0, 0); PG8_STAGE(PG8_SA(1, 1), a1 + hstep, voffA);
            PG8_WAIT_L(8); PG8_BAR; PG8_WAIT_L(0); PG8_MMA(0, 0, At, B0); PG8_BAR; PG8_SCHED;
            PG8_LDB(B1, 0, 1); PG8_STAGE(PG8_SB(0, 0), b2, voffB);
            PG8_BAR; PG8_WAIT_L(0); PG8_MMA(0, 1, At, B1); PG8_BAR;
            PG8_LDA(At, 0, 1); PG8_STAGE(PG8_SA(0, 0), a2, voffA);
            PG8_BAR; PG8_WAIT_L(0); PG8_MMA(1, 0, At, B0); PG8_BAR; PG8_SCHED;
            PG8_STAGE(PG8_SB(0, 1), b2 + hstep, voffB);
            PG8_WAIT_V(6); PG8_BAR; PG8_MMA(1, 1, At, B1); PG8_BAR;
            PG8_LDB(B0, 1, 0); PG8_SCHED; PG8_LDA(At, 1, 0); PG8_STAGE(PG8_SA(0, 1), a2 + hstep, voffA);
            PG8_WAIT_L(8); PG8_BAR; PG8_WAIT_L(0); PG8_MMA(0, 0, At, B0); PG8_BAR; PG8_SCHED;
            PG8_LDB(B1, 1, 1); PG8_STAGE(PG8_SB(1, 0), b3, voffB);
            PG8_BAR; PG8_WAIT_L(0); PG8_MMA(0, 1, At, B1); PG8_BAR;
            PG8_LDA(At, 1, 1); PG8_STAGE(PG8_SA(1, 0), a3, voffA);
            PG8_BAR; PG8_WAIT_L(0); PG8_MMA(1, 0, At, B0); PG8_BAR; PG8_SCHED;
            PG8_STAGE(PG8_SB(1, 1), b3 + hstep, voffB);
            PG8_WAIT_V(6); PG8_BAR; PG8_MMA(1, 1, At, B1); PG8_BAR;
            }
        }
        if constexpr (ALIGN_EPI) { if (wr == 0) PG8_BAR; }
        if constexpr (!Epi::AFTER_DRAIN) { E(acc, cur, wr, wc, fr, fq); S.done(cur); }
        if (!has_next) break;
#pragma unroll
        for (int a = 0; a < 2; ++a)
#pragma unroll
            for (int b = 0; b < 2; ++b)
#pragma unroll
                for (int m = 0; m < 4; ++m)
#pragma unroll
                    for (int n = 0; n < 2; ++n) acc[a][b][m][n] = (f32x4){0.f, 0.f, 0.f, 0.f};
        cur = nxt; cA = nA; cB = nB; ++ui;
        if constexpr (ALIGN_EPI) { if (wr == 1) PG8_BAR; }
    }
    PG8_WAIT_V(0);
    if constexpr (!ALIGN_EPI) { if (wr == 0) PG8_BAR; }
    PG8_BAR;
    if constexpr (Epi::AFTER_DRAIN) { E.fused(acc, cur, wr, wc, fr, fq, lds, wid, lane); S.done(cur); }
#undef PG8_SA
#undef PG8_SB
#undef PG8_STAGE
#undef PG8_LDA
#undef PG8_LDB
#undef PG8_MMA
#undef PG8_WAIT_V
#undef PG8_WAIT_L
#undef PG8_BAR
#undef PG8_SCHED
}
}

constexpr int NWAVES = 8;
constexpr int N_LAUNCHES = MK_N_LAUNCHES;
constexpr int PER_PHASE = 6;
constexpr int DM = 2048, BATCH = 4, SEQ = 2048, MROWS = BATCH * SEQ, NIN = 8192, CHUNK = 64, NCH = SEQ / CHUNK, NH = 8, DH = 128;
constexpr int LDP = NIN;
constexpr int C_AQ = 0, C_AK = 1024, C_AV = 2048, C_AZ = 3072, C_GQ = 4096, C_GF = 5120, C_GI = 6144, C_GZ = 7168;
constexpr float EPS = 1e-6f, LOG2E = 1.4426950408889634f;

constexpr size_t MiB = 1u << 20;
constexpr size_t WS_CTL = 0, CTL_ZERO_BYTES = 1 * MiB;
constexpr size_t WS_WIN = 2 * MiB;
constexpr size_t WS_UT = 2 * MiB;
constexpr size_t WS_WOUT = 34 * MiB;
constexpr size_t WS_H = 42 * MiB;
constexpr size_t WS_MIX = 42 * MiB;
constexpr size_t WS_PROJ = 74 * MiB;
constexpr size_t WS_DL = 202 * MiB;
constexpr size_t WS_END = 203 * MiB;
constexpr int CW_BAR = 4096;
constexpr int CW_MOD = 131072;
static_assert((CW_MOD + 4 * 6144) * 4 <= (int)CTL_ZERO_BYTES, "ctl map");

constexpr int RING_OFF = 0, RING_BYTES = 131072;
constexpr int LDSCTL_OFF = RING_BYTES, MISC_OFF = LDSCTL_OFF + 320;
constexpr int LDS_BYTES = 147456;

#define GAS __attribute__((address_space(1)))
#define LAS __attribute__((address_space(3)))
typedef unsigned short bf16;
typedef unsigned v4u __attribute__((ext_vector_type(4)));
typedef unsigned v2u __attribute__((ext_vector_type(2)));
typedef float f32x4 __attribute__((ext_vector_type(4)));
typedef float f32x16 __attribute__((ext_vector_type(16)));
typedef short bf16x8 __attribute__((ext_vector_type(8)));
typedef short s16x4 __attribute__((ext_vector_type(4)));
typedef GAS unsigned gu32;
#define RLX_AGENT __ATOMIC_RELAXED, __HIP_MEMORY_SCOPE_AGENT
#define LDS_WAIT() asm volatile("s_waitcnt lgkmcnt(0)" ::: "memory")
#define VM_WAIT() asm volatile("s_waitcnt vmcnt(0)" ::: "memory")
__device__ __forceinline__ unsigned f2bf(float f) { unsigned u = __builtin_bit_cast(unsigned, f); return (u + 0x7fffu + ((u >> 16) & 1u)) >> 16; }
__device__ __forceinline__ unsigned pk2(float lo, float hi) { return f2bf(lo) | (f2bf(hi) << 16); }
__device__ __forceinline__ float bf2f(unsigned short h) { return __builtin_bit_cast(float, (unsigned)h << 16); }
__device__ __forceinline__ float bflo(unsigned w) { return __builtin_bit_cast(float, w << 16); }
__device__ __forceinline__ float bfhi(unsigned w) { return __builtin_bit_cast(float, w & 0xffff0000u); }
__device__ __forceinline__ float fexp(float x) { return __builtin_amdgcn_exp2f(x * LOG2E); }
__device__ __forceinline__ float silu1(float v) { return v * __builtin_amdgcn_rcpf(1.0f + __builtin_amdgcn_exp2f(-LOG2E * v)); }

#define XB_TMO      128
#define XB_XCNT(j)  (256  + 64 * (j))
#define XB_XSUB(j)  (1280 + 64 * (j))
#define XB_XGEN(j)  (2304 + 64 * (j))
#define XB_TOP      3328
#define XB_TOPGEN   3392
#define XCD_BAR_WORDS 3456
#define XB_SPIN_CAP (1u << 18)

__device__ __forceinline__ unsigned xb_ld(unsigned* p)              { return __hip_atomic_load(p, __ATOMIC_RELAXED, __HIP_MEMORY_SCOPE_AGENT); }
__device__ __forceinline__ unsigned xb_add(unsigned* p, unsigned v) { return __hip_atomic_fetch_add(p, v, __ATOMIC_RELAXED, __HIP_MEMORY_SCOPE_AGENT); }
__device__ __forceinline__ unsigned xb_xcc_id() { return (unsigned)__builtin_amdgcn_s_getreg((3 << 11) | 20) & 0xFu; }
#define XB_SPIN(cond, bar) do { unsigned _sp = 0; while (cond) { __builtin_amdgcn_s_sleep(1); \
    if ((++_sp & 255u) == 0u) { if (xb_ld(&(bar)[XB_TMO])) break; if (_sp > XB_SPIN_CAP) { atomicAdd(&(bar)[XB_TMO], 1u); break; } } } } while (0)

struct XcdBarrier {
    unsigned* bar; unsigned x;
    volatile LAS unsigned* st;
};

__device__ __forceinline__ XcdBarrier xcd_barrier_post(unsigned* bar, volatile LAS unsigned* st) {
    XcdBarrier b; b.bar = bar; b.x = xb_xcc_id(); b.st = st;
    if (threadIdx.x == 0) (void)xb_add(&bar[XB_XCNT(b.x)], 1u);
    return b;
}
__device__ __forceinline__ void xcd_barrier_complete(unsigned* bar, unsigned x, unsigned& nloc, unsigned& nx) {
    const unsigned G = gridDim.x * gridDim.y * gridDim.z;
    unsigned sum, cnt, mine, sp = 0u;
    for (;;) {
        sum = 0u; cnt = 0u; mine = 0u;
#pragma unroll
        for (unsigned j = 0; j < 16; ++j) { const unsigned c = xb_ld(&bar[XB_XCNT(j)]); sum += c; cnt += (c > 0u) ? 1u : 0u; mine = (j == x) ? c : mine; }
        if (sum == G) break;
        __builtin_amdgcn_s_sleep(1);
        if ((++sp & 255u) == 0u) { if (xb_ld(&bar[XB_TMO])) break; if (sp > XB_SPIN_CAP) { atomicAdd(&bar[XB_TMO], 1u); break; } }
    }
    nloc = mine > 0u ? mine : 1u; nx = cnt > 0u ? cnt : 1u;
}

__device__ __forceinline__ void xcd_barrier(const XcdBarrier& b) {
    asm volatile("s_waitcnt vmcnt(0)" ::: "memory");
    __syncthreads();
    if (threadIdx.x == 0) {
        unsigned* bar = b.bar;
        __builtin_amdgcn_s_waitcnt(0);
        unsigned nloc = b.st[0], nx = b.st[1];
        if (nloc == 0u) { xcd_barrier_complete(bar, b.x, nloc, nx); b.st[0] = nloc; b.st[1] = nx; }
        const unsigned old = xb_add(&bar[XB_XSUB(b.x)], 1u);
        const unsigned gen = old / nloc;
        if (old + 1u == (gen + 1u) * nloc) {
            __builtin_amdgcn_fence(__ATOMIC_RELEASE, "agent");
            asm volatile("s_waitcnt vmcnt(0)" ::: "memory");
            const unsigned og = xb_add(&bar[XB_TOP], 1u);
            const unsigned tg = og / nx;
            if (og + 1u == (tg + 1u) * nx) xb_add(&bar[XB_TOPGEN], 1u);
            else XB_SPIN(xb_ld(&bar[XB_TOPGEN]) == tg, bar);
            __builtin_amdgcn_fence(__ATOMIC_ACQUIRE, "agent");
            xb_add(&bar[XB_XGEN(b.x)], 1u);
            asm volatile("s_waitcnt vmcnt(0)" ::: "memory");
        } else {
            XB_SPIN(xb_ld(&bar[XB_XGEN(b.x)]) == gen, bar);
            __builtin_amdgcn_fence(__ATOMIC_ACQUIRE, "agent");
            asm volatile("s_waitcnt vmcnt(0)" ::: "memory");
        }
    }
    __syncthreads();
}

struct Frame {
    LAS unsigned char* lds;
    volatile LAS unsigned* MISC;
    gu32* ctl;
    int tid, lane, wave;
    int vcu, G;
    const float *x, *c, *norm_g, *w_ada, *b_ada, *w_in, *q_g, *k_g, *rel_bias, *lower_bounds, *hg_g, *w_out;
    float* out;
    float* mod;
    bf16 *WIN, *WOUT, *HB, *MIX, *PROJ, *UT; float* DL;
};

__device__ __forceinline__ float wave_sum(float v) {
#pragma unroll
    for (int o = 1; o < 64; o <<= 1) v += __shfl_xor(v, o);
    return v;
}
__device__ __forceinline__ void p0_transpose_item(const float* W, int K, int N, bf16* WT, LAS float* scr, int item, int lane) {
    const int nblk = N / 32, kb = item / nblk, nb = item % nblk, k0 = 64 * kb, n0 = 32 * nb;
#pragma unroll 8
    for (int i = 0; i < 32; ++i) { const int kk = 2 * i + (lane >> 5); scr[kk * 33 + (lane & 31)] = W[(size_t)(k0 + kk) * N + n0 + (lane & 31)]; }
    LDS_WAIT(); asm volatile("" ::: "memory");
    const int c = lane & 7;
#pragma unroll
    for (int j = 0; j < 4; ++j) { const int n = (lane >> 3) + 8 * j; const LAS float* s = scr + (8 * c) * 33 + n;
        v4u o; o.x = pk2(s[0 * 33], s[1 * 33]); o.y = pk2(s[2 * 33], s[3 * 33]); o.z = pk2(s[4 * 33], s[5 * 33]); o.w = pk2(s[6 * 33], s[7 * 33]);
        *(GAS v4u*)(WT + (size_t)(n0 + n) * K + k0 + 8 * c) = o; }
    LDS_WAIT(); asm volatile("" ::: "memory");
}
__device__ __forceinline__ void p0_ada_item(Frame& F, int item) {
    const int kc = item / 24, cc = item % 24, k0 = 64 * kc, col = 256 * cc + 4 * F.lane;
    float ca[4];
#pragma unroll
    for (int b = 0; b < 4; ++b) ca[b] = silu1(F.c[b * DM + k0 + F.lane]);
    f32x4 acc[4];
#pragma unroll
    for (int b = 0; b < 4; ++b) acc[b] = (f32x4){0.f, 0.f, 0.f, 0.f};
    const GAS f32x4* wp = (const GAS f32x4*)(F.w_ada + (size_t)k0 * 6144 + col);
#pragma unroll 16
    for (int k = 0; k < 64; ++k) {
        const f32x4 w = wp[(size_t)k * (6144 / 4)];
#pragma unroll
        for (int b = 0; b < 4; ++b) { const float s = __shfl(ca[b], k); acc[b] += w * s; }
    }
    if (kc == 0) { const f32x4 bv = *(const f32x4*)(F.b_ada + col);
#pragma unroll
        for (int b = 0; b < 4; ++b) acc[b] += bv; }
#pragma unroll
    for (int b = 0; b < 4; ++b)
#pragma unroll
        for (int i = 0; i < 4; ++i) __hip_atomic_fetch_add(F.mod + b * 6144 + col + i, acc[b][i], RLX_AGENT);
}
__device__ __forceinline__ void p0_prologue(Frame& F) {
    LAS float* scr = (LAS float*)(F.lds + RING_OFF + F.wave * 16384);
    const int gw = F.vcu * NWAVES + F.wave, NGW = F.G * NWAVES;
    constexpr int I_ADA = 32 * 24, I_IN = (DM / 64) * (NIN / 32), I_OUT = (DM / 64) * (DM / 32);
    constexpr int NITEMS = I_ADA + I_IN + I_OUT;
    for (int it = gw; it < NITEMS; it += NGW) {
        int r = it;
        if (r < I_ADA) { p0_ada_item(F, r); continue; } r -= I_ADA;
        if (r < I_IN) { p0_transpose_item(F.w_in, DM, NIN, F.WIN, scr, r, F.lane); continue; } r -= I_IN;
        p0_transpose_item(F.w_out, DM, DM, F.WOUT, scr, r, F.lane);
    }
}
__device__ __forceinline__ void p1_rows(Frame& F) {
    const int gw = F.vcu * NWAVES + F.wave, NGW = F.G * NWAVES;
    for (int m = gw; m < MROWS; m += NGW) {
        const int b = m / SEQ;
        const GAS f32x4* xr = (const GAS f32x4*)(F.x + (size_t)m * DM) + F.lane;
        f32x4 v[8]; float s = 0.f;
#pragma unroll
        for (int j = 0; j < 8; ++j) { v[j] = xr[64 * j]; s += (v[j].x * v[j].x + v[j].y * v[j].y) + (v[j].z * v[j].z + v[j].w * v[j].w); }
        const float rinv = 1.0f / sqrtf(wave_sum(s) * (1.f / DM) + EPS);
        const GAS f32x4* gp = (const GAS f32x4*)F.norm_g + F.lane;
        const GAS f32x4* shp = (const GAS f32x4*)(F.mod + b * 6144) + F.lane;
        const GAS f32x4* scp = (const GAS f32x4*)(F.mod + b * 6144 + DM) + F.lane;
        GAS unsigned long long* o8 = (GAS unsigned long long*)(F.HB + (size_t)m * DM) + F.lane;
#pragma unroll
        for (int j = 0; j < 8; ++j) { const f32x4 g = gp[64 * j], sh = shp[64 * j], sc = scp[64 * j];
            const f32x4 hv = (v[j] * rinv) * g * (sc + 1.0f) + sh;
            o8[64 * j] = (unsigned long long)pk2(hv.x, hv.y) | ((unsigned long long)pk2(hv.z, hv.w) << 32); }
    }
}

__device__ __forceinline__ void p3_qknorm(Frame& F) {
    const int gw = F.vcu * NWAVES + F.wave, NGW = F.G * NWAVES;
    const int seg = F.lane >> 4, l16 = F.lane & 15;
    for (int it = gw; it < MROWS * 4; it += NGW) {
        const int m = it >> 2, g = it & 3;
        const int col = (g * 4 + seg) * 128 + l16 * 8;
        bf16* p = F.PROJ + (size_t)m * LDP + col;
        const v4u w = *(const GAS v4u*)p;
        float v[8] = {bflo(w.x), bfhi(w.x), bflo(w.y), bfhi(w.y), bflo(w.z), bfhi(w.z), bflo(w.w), bfhi(w.w)};
        float ss = 0.f;
#pragma unroll
        for (int i = 0; i < 8; ++i) ss += v[i] * v[i];
        ss += __shfl_xor(ss, 1); ss += __shfl_xor(ss, 2); ss += __shfl_xor(ss, 4); ss += __shfl_xor(ss, 8);
        float r = 1.0f / sqrtf(ss * (1.f / DH) + EPS);
        const bool isq = col < 1024;
        if (isq) r *= 0.08838834764831845f * LOG2E;
        const float* gp = (isq ? F.q_g : F.k_g) + l16 * 8;
        const f32x4 g0 = *(const f32x4*)gp, g1 = *(const f32x4*)(gp + 4);
        v4u o; o.x = pk2(v[0] * r * g0.x, v[1] * r * g0.y); o.y = pk2(v[2] * r * g0.z, v[3] * r * g0.w);
        o.z = pk2(v[4] * r * g1.x, v[5] * r * g1.y); o.w = pk2(v[6] * r * g1.z, v[7] * r * g1.w);
        *(GAS v4u*)p = o;
    }
}

constexpr int HP_QT = 0, HP_KT = 17408, HP_KDT = 60928, HP_VT = 79360, HP_AM = 97792, HP_QTOT = 107008, HP_RREF = 109056;
constexpr int QS = 136, TS = 72;
__device__ __forceinline__ void hg_prep_item(Frame& F, int item) {
    const int b = item >> 8, n = (item >> 3) & 31, h = item & 7;
    const int tid = F.tid, lane = F.lane, d = tid & 127, qtr = __builtin_amdgcn_readfirstlane(tid >> 7);
    const size_t m0 = (size_t)b * SEQ + (size_t)n * CHUNK;
    LAS bf16* QT = (LAS bf16*)(F.lds + HP_QT); LAS bf16* KT = (LAS bf16*)(F.lds + HP_KT); LAS bf16* KDT = (LAS bf16*)(F.lds + HP_KDT);
    LAS bf16* VT = (LAS bf16*)(F.lds + HP_VT); LAS bf16* AM = (LAS bf16*)(F.lds + HP_AM);
    LAS float* QTOT = (LAS float*)(F.lds + HP_QTOT); LAS float* RREF = (LAS float*)(F.lds + HP_RREF);
    const float l0 = F.lower_bounds[h * 128 + d], l1 = F.lower_bounds[1024 + h * 128 + d];
    const float lb = 1.0f / (1.0f + fexp(l1 - l0)), oml = 1.0f - lb;
    bf16* prow = F.PROJ + (m0 + 16 * qtr) * LDP + h * 128 + d;
    float q[16], kk[16], bb[16]; unsigned short vv[16];
    float run = 0.f;
#pragma unroll
    for (int i = 0; i < 16; ++i) {
        const float fr = bf2f(prow[(size_t)i * LDP + C_GF]); q[i] = bf2f(prow[(size_t)i * LDP + C_GQ]); vv[i] = prow[(size_t)i * LDP + C_GI];
        const float sg = __builtin_amdgcn_rcpf(1.0f + __builtin_amdgcn_exp2f(-LOG2E * fr));
        const float f = lb + oml * sg;
        run += __builtin_amdgcn_logf(f) * 0.6931471805599453f;
        bb[i] = run; kk[i] = oml * (1.0f - sg);
    }
    QTOT[qtr * 128 + d] = run;
    __syncthreads();
    float prefix = 0.f, total = 0.f;
#pragma unroll
    for (int j = 0; j < 4; ++j) { const float t = QTOT[j * 128 + d]; if (j < qtr) prefix += t; total += t; }
#pragma unroll
    for (int i = 0; i < 16; ++i) bb[i] += prefix;
    const float rown = bb[7];
    RREF[qtr * 128 + d] = rown;
    __syncthreads();
    float rr[4];
#pragma unroll
    for (int j = 0; j < 4; ++j) rr[j] = RREF[j * 128 + d];
#pragma unroll
    for (int i = 0; i < 16; ++i) QT[(16 * qtr + i) * QS + d] = (bf16)f2bf(q[i] * fexp(bb[i] - rown));
#pragma unroll
    for (int I = 0; I < 4; ++I) {
        if (I >= qtr) { const int pair = I * (I + 1) / 2 + qtr;
#pragma unroll
            for (int i = 0; i < 16; ++i) KT[pair * (16 * QS) + i * QS + d] = (bf16)f2bf(kk[i] * fexp(rr[I] - bb[i])); }
    }
    { unsigned kw[8], vw[8];
#pragma unroll
      for (int i = 0; i < 8; ++i) { kw[i] = pk2(kk[2 * i] * fexp(total - bb[2 * i]), kk[2 * i + 1] * fexp(total - bb[2 * i + 1])); vw[i] = (unsigned)vv[2 * i] | ((unsigned)vv[2 * i + 1] << 16); }
      LAS v4u* kp = (LAS v4u*)(KDT + d * TS + 16 * qtr); kp[0] = (v4u){kw[0], kw[1], kw[2], kw[3]}; kp[1] = (v4u){kw[4], kw[5], kw[6], kw[7]};
      LAS v4u* vp = (LAS v4u*)(VT + d * TS + 16 * qtr);  vp[0] = (v4u){vw[0], vw[1], vw[2], vw[3]}; vp[1] = (v4u){vw[4], vw[5], vw[6], vw[7]}; }
#pragma unroll
    for (int i = 0; i < 16; ++i) prow[(size_t)i * LDP + C_GQ] = (bf16)f2bf(q[i] * fexp(bb[i]));
    if (qtr == 0) F.DL[(size_t)item * 128 + d] = fexp(total);
    __syncthreads();
    const int c = lane & 15, g = lane >> 4, w = F.wave;
#pragma unroll
    for (int rep = 0; rep < 2; ++rep) {
        const int idx = w + 8 * rep;
        if (idx < 10) {
            const int I = (idx >= 6) ? 3 : (idx >= 3) ? 2 : (idx >= 1) ? 1 : 0, J = idx - I * (I + 1) / 2;
            f32x4 acc = {0.f, 0.f, 0.f, 0.f};
#pragma unroll
            for (int ks = 0; ks < 4; ++ks) {
                const bf16x8 a = *(const LAS bf16x8*)(KT + idx * (16 * QS) + c * QS + 32 * ks + 8 * g);
                const bf16x8 bq = *(const LAS bf16x8*)(QT + (16 * I + c) * QS + 32 * ks + 8 * g);
                acc = __builtin_amdgcn_mfma_f32_16x16x32_bf16(a, bq, acc, 0, 0, 0);
            }
            if (I == J) {
#pragma unroll
                for (int r = 0; r < 4; ++r) if (4 * g + r > c) acc[r] = 0.f; }
            *(LAS v2u*)(AM + (16 * I + c) * TS + 16 * J + 4 * g) = (v2u){pk2(acc[0], acc[1]), pk2(acc[2], acc[3])};
        } else if (idx < 12) {
            const int I = (idx == 10) ? 0 : 2, J = I + 1;
            *(LAS v2u*)(AM + (16 * I + c) * TS + 16 * J + 4 * g) = (v2u){0u, 0u};
        }
    }
    __syncthreads();
    bf16x8 vf[2];
#pragma unroll
    for (int ks = 0; ks < 2; ++ks) vf[ks] = *(const LAS bf16x8*)(VT + (16 * w + c) * TS + 32 * ks + 8 * g);
#pragma unroll
    for (int tt = 0; tt < 4; ++tt) {
        f32x4 acc = {0.f, 0.f, 0.f, 0.f};
#pragma unroll
        for (int ks = 0; ks < 2; ++ks) { if (ks == 1 && tt < 2) continue;
            const bf16x8 am = *(const LAS bf16x8*)(AM + (16 * tt + c) * TS + 32 * ks + 8 * g);
            acc = __builtin_amdgcn_mfma_f32_16x16x32_bf16(vf[ks], am, acc, 0, 0, 0); }
        *(GAS v2u*)(F.PROJ + (m0 + 16 * tt + c) * LDP + C_GF + h * 128 + 16 * w + 4 * g) = (v2u){pk2(acc[0], acc[1]), pk2(acc[2], acc[3])};
    }
#pragma unroll
    for (int dt = 0; dt < 8; ++dt) {
        f32x4 acc = {0.f, 0.f, 0.f, 0.f};
#pragma unroll
        for (int ks = 0; ks < 2; ++ks) {
            const bf16x8 kd = *(const LAS bf16x8*)(KDT + (16 * dt + c) * TS + 32 * ks + 8 * g);
            acc = __builtin_amdgcn_mfma_f32_16x16x32_bf16(kd, vf[ks], acc, 0, 0, 0); }
        *(GAS v2u*)(F.UT + ((size_t)item * 128 + 16 * w + c) * 128 + 16 * dt + 4 * g) = (v2u){pk2(acc[0], acc[1]), pk2(acc[2], acc[3])};
    }
    __syncthreads();
}

__device__ __forceinline__ void hg_scan(Frame& F, int bh) {
    const int b = bh >> 3, h = bh & 7, w = F.wave, lane = F.lane, c = lane & 15, g = lane >> 4, e0 = 16 * w;
    LAS float* SSQ = (LAS float*)(F.lds);
    float S[4][8];
#pragma unroll
    for (int ks = 0; ks < 4; ++ks)
#pragma unroll
        for (int j = 0; j < 8; ++j) S[ks][j] = 0.f;
    const f32x4 og = *(const f32x4*)(F.hg_g + e0 + 4 * g);
    for (int n = 0; n < NCH; ++n) {
        const int item = (b << 8) | (n << 3) | h; const size_t m0 = (size_t)b * SEQ + (size_t)n * CHUNK;
        bf16x8 sf[4];
#pragma unroll
        for (int ks = 0; ks < 4; ++ks) { v4u t; t.x = pk2(S[ks][0], S[ks][1]); t.y = pk2(S[ks][2], S[ks][3]); t.z = pk2(S[ks][4], S[ks][5]); t.w = pk2(S[ks][6], S[ks][7]); sf[ks] = __builtin_bit_cast(bf16x8, t); }
        f32x4 o[4];
#pragma unroll
        for (int mt = 0; mt < 4; ++mt) {
            const bf16* rowp = F.PROJ + (m0 + 16 * mt + c) * LDP + h * 128;
            f32x4 acc = {0.f, 0.f, 0.f, 0.f};
#pragma unroll
            for (int ks = 0; ks < 4; ++ks) { const bf16x8 qf = *(const GAS bf16x8*)(rowp + C_GQ + 32 * ks + 8 * g); acc = __builtin_amdgcn_mfma_f32_16x16x32_bf16(sf[ks], qf, acc, 0, 0, 0); }
            const v2u iw = *(const GAS v2u*)(rowp + C_GF + e0 + 4 * g);
            acc[0] += bflo(iw.x); acc[1] += bfhi(iw.x); acc[2] += bflo(iw.y); acc[3] += bfhi(iw.y);
            o[mt] = acc;
            float ss = (acc[0] * acc[0] + acc[1] * acc[1]) + (acc[2] * acc[2] + acc[3] * acc[3]);
            ss += __shfl_xor(ss, 16); ss += __shfl_xor(ss, 32);
            if (g == 0) SSQ[(n & 1) * 512 + w * 64 + 16 * mt + c] = ss;
        }
        __syncthreads();
#pragma unroll
        for (int mt = 0; mt < 4; ++mt) {
            float tot = 0.f;
#pragma unroll
            for (int ww = 0; ww < 8; ++ww) tot += SSQ[(n & 1) * 512 + ww * 64 + 16 * mt + c];
            const float rinv = 1.0f / sqrtf(tot * (1.f / 128.f) + EPS);
            const bf16* rowp = F.PROJ + (m0 + 16 * mt + c) * LDP + h * 128;
            const v2u gw = *(const GAS v2u*)(rowp + C_GZ + e0 + 4 * g);
            const f32x4 v = o[mt] * rinv * og;
            *(GAS v2u*)(F.MIX + (m0 + 16 * mt + c) * DM + 1024 + h * 128 + e0 + 4 * g) = (v2u){pk2(v[0] * bflo(gw.x), v[1] * bfhi(gw.x)), pk2(v[2] * bflo(gw.y), v[3] * bfhi(gw.y))};
        }
#pragma unroll
        for (int ks = 0; ks < 4; ++ks) {
            const v4u uw = *(const GAS v4u*)(F.UT + ((size_t)item * 128 + e0 + c) * 128 + 32 * ks + 8 * g);
            const f32x4 d0 = *(const GAS f32x4*)(F.DL + (size_t)item * 128 + 32 * ks + 8 * g), d1 = *(const GAS f32x4*)(F.DL + (size_t)item * 128 + 32 * ks + 8 * g + 4);
            S[ks][0] = d0.x * S[ks][0] + bflo(uw.x); S[ks][1] = d0.y * S[ks][1] + bfhi(uw.x); S[ks][2] = d0.z * S[ks][2] + bflo(uw.y); S[ks][3] = d0.w * S[ks][3] + bfhi(uw.y);
            S[ks][4] = d1.x * S[ks][4] + bflo(uw.z); S[ks][5] = d1.y * S[ks][5] + bfhi(uw.z); S[ks][6] = d1.z * S[ks][6] + bflo(uw.w); S[ks][7] = d1.w * S[ks][7] + bfhi(uw.w);
        }
    }
    __syncthreads();
}

namespace att {
constexpr int SHM_V = 16384, SHM_K = 16384, A_WS = 2 * SHM_V + 2 * SHM_K, A_BIAS = A_WS + NWAVES * 64 * 4, A_END = A_BIAS + 1040;
constexpr float THR2 = 8.0f * LOG2E;
#define KSWZ(row, colB) ((row) * 256 + ((colB) ^ (((row) & 7) << 4)))
#define SBAR() __builtin_amdgcn_sched_barrier(0)
__device__ __forceinline__ int crow(int r, int hi) { return (r & 3) + 8 * (r >> 2) + 4 * hi; }
__device__ __forceinline__ unsigned cvtpk(float lo, float hi) { unsigned r; asm volatile("v_cvt_pk_bf16_f32 %0, %1, %2" : "=v"(r) : "v"(lo), "v"(hi)); return r; }
__device__ __forceinline__ void partialSM(f32x16& p0, f32x16& p1, float& m_reg, float& alpha) {
  float pmax = p0[0];
#pragma unroll
  for (int r = 1; r < 16; ++r) pmax = fmaxf(pmax, p0[r]);
#pragma unroll
  for (int r = 0; r < 16; ++r) pmax = fmaxf(pmax, p1[r]);
  { auto rr = __builtin_amdgcn_permlane32_swap(__float_as_uint(pmax), __float_as_uint(pmax), false, false);
    pmax = fmaxf(__uint_as_float(rr[0]), __uint_as_float(rr[1])); }
  float mn;
  if (__builtin_expect(__all(pmax - m_reg <= THR2), 1)) { mn = m_reg; alpha = 1.f; }
  else { mn = fmaxf(m_reg, pmax); alpha = __builtin_amdgcn_exp2f(m_reg - mn); m_reg = mn; }
#pragma unroll
  for (int r = 0; r < 16; ++r) p0[r] = __builtin_amdgcn_exp2f(p0[r] - mn);
#pragma unroll
  for (int r = 0; r < 16; ++r) p1[r] = __builtin_amdgcn_exp2f(p1[r] - mn);
}
__device__ __forceinline__ void finishSM(f32x16& p0, f32x16& p1, float alpha, float& l_reg, bf16x8& pa0, bf16x8& pa1, bf16x8& pa2, bf16x8& pa3) {
  float ps = 0;
#pragma unroll
  for (int r = 0; r < 16; ++r) ps += p0[r];
#pragma unroll
  for (int r = 0; r < 16; ++r) ps += p1[r];
  { auto rr = __builtin_amdgcn_permlane32_swap(__float_as_uint(ps), __float_as_uint(ps), false, false);
    ps = __uint_as_float(rr[0]) + __uint_as_float(rr[1]); }
  l_reg = l_reg * alpha + ps;
#define PK4(P, BASE, OUT) do { unsigned a0 = cvtpk(P[BASE + 0], P[BASE + 1]), a1 = cvtpk(P[BASE + 2], P[BASE + 3]);   \
    unsigned b0 = cvtpk(P[BASE + 4], P[BASE + 5]), b1 = cvtpk(P[BASE + 6], P[BASE + 7]);                              \
    auto r0 = __builtin_amdgcn_permlane32_swap(a0, b0, false, false); auto r1 = __builtin_amdgcn_permlane32_swap(a1, b1, false, false); \
    v4u w_ = {r0[0], r1[0], r0[1], r1[1]}; OUT = __builtin_bit_cast(bf16x8, w_); } while (0)
  PK4(p0, 0, pa0); PK4(p0, 8, pa1); PK4(p1, 0, pa2); PK4(p1, 8, pa3);
#undef PK4
}
__device__ __forceinline__ void qkt(f32x16& p0, f32x16& p1, const LAS char* Ks, const bf16x8* qr, int r32, int hi) {
  p0 = f32x16{}; p1 = f32x16{};
#pragma unroll
  for (int d0 = 0; d0 < 8; ++d0) { const int cb = (d0 * 16 + hi * 8) * 2;
    const bf16x8 b0 = *(const LAS bf16x8*)(Ks + KSWZ(r32, cb));
    const bf16x8 b1 = *(const LAS bf16x8*)(Ks + KSWZ(32 + r32, cb));
    p0 = __builtin_amdgcn_mfma_f32_32x32x16_bf16(b0, qr[d0], p0, 0, 0, 0);
    p1 = __builtin_amdgcn_mfma_f32_32x32x16_bf16(b1, qr[d0], p1, 0, 0, 0); }
}
__device__ __forceinline__ int v_st(int k, int c) { const int kk = (k & ~0xC) | ((k & 4) << 1) | ((k & 8) >> 1); return ((kk >> 3) * 4 + (c >> 5)) * 512 + ((kk & 7) * 32 + (c & 31)) * 2; }
__device__ __forceinline__ int v_rd_base(int lane) { return ((lane & 3) << 3) | (((lane >> 2) & 3) << 6) | (((lane >> 4) & 1) << 5) | (((lane >> 5) & 1) << 8); }
constexpr int v_rd_off(int d0, int ks, int half) { return d0 * 512 + ks * 4096 + half * 2048; }
template <int OFF> __device__ __forceinline__ s16x4 tr_read(int vb) {
  s16x4 r; asm volatile("ds_read_b64_tr_b16 %0, %1 offset:%2" : "=&v"(r) : "v"(vb), "i"(OFF) : "memory"); return r;
}
template <int D0> __device__ __forceinline__ void pv_one(f32x16& od, int vb, bf16x8 pa0, bf16x8 pa1, bf16x8 pa2, bf16x8 pa3) {
  const s16x4 l0 = tr_read<v_rd_off(D0, 0, 0)>(vb), h0 = tr_read<v_rd_off(D0, 0, 1)>(vb), l1 = tr_read<v_rd_off(D0, 1, 0)>(vb), h1 = tr_read<v_rd_off(D0, 1, 1)>(vb);
  const s16x4 l2 = tr_read<v_rd_off(D0, 2, 0)>(vb), h2 = tr_read<v_rd_off(D0, 2, 1)>(vb), l3 = tr_read<v_rd_off(D0, 3, 0)>(vb), h3 = tr_read<v_rd_off(D0, 3, 1)>(vb);
  asm volatile("s_waitcnt lgkmcnt(0)" ::: "memory"); SBAR();
#define PK(L, H) (bf16x8){L[0], L[1], L[2], L[3], H[0], H[1], H[2], H[3]}
  od = __builtin_amdgcn_mfma_f32_32x32x16_bf16(pa0, PK(l0, h0), od, 0, 0, 0);
  od = __builtin_amdgcn_mfma_f32_32x32x16_bf16(pa1, PK(l1, h1), od, 0, 0, 0);
  od = __builtin_amdgcn_mfma_f32_32x32x16_bf16(pa2, PK(l2, h2), od, 0, 0, 0);
  od = __builtin_amdgcn_mfma_f32_32x32x16_bf16(pa3, PK(l3, h3), od, 0, 0, 0);
#undef PK
}
__device__ __forceinline__ void pv_d0(f32x16* o, int vb, bf16x8 pa0, bf16x8 pa1, bf16x8 pa2, bf16x8 pa3) {
  pv_one<0>(o[0], vb, pa0, pa1, pa2, pa3); pv_one<1>(o[1], vb, pa0, pa1, pa2, pa3); pv_one<2>(o[2], vb, pa0, pa1, pa2, pa3); pv_one<3>(o[3], vb, pa0, pa1, pa2, pa3);
}

__device__ __forceinline__ void attn_unit(int b, int h, int u, const bf16* PROJ, bf16* MIX, const float* rel_bias, LAS unsigned char* lds) {
  const int tid = threadIdx.x, lane = tid & 63, r32 = lane & 31, hi = lane >> 5; const int wid = __builtin_amdgcn_readfirstlane(tid >> 6);
  LAS char* V_lds = (LAS char*)lds; LAS char* K_lds = (LAS char*)lds + 2 * SHM_V;
  LAS float* ws = (LAS float*)(lds + A_WS) + wid * 64; LAS float* li_l = ws; LAS float* al_l = ws + 32;
  LAS float* bl = (LAS float*)(lds + A_BIAS);
  if (tid < 257) { const float far = rel_bias[h * 257 + 256]; bl[tid] = (rel_bias[h * 257 + tid] - far) * LOG2E; }
  float m_reg = -1e30f, l_reg = 0; f32x16 o[4] = {}; bf16x8 qr[8];
  const size_t mrow0 = (size_t)b * SEQ + 256 * u;
  const bf16* Qw = PROJ + (mrow0 + wid * 32 + r32) * LDP + C_AQ + h * 128 + hi * 8;
#pragma unroll
  for (int d0 = 0; d0 < 8; ++d0) qr[d0] = *(const GAS bf16x8*)(Qw + d0 * 16);
  const bf16* Kh = PROJ + (size_t)b * SEQ * LDP + C_AK + h * 128; const bf16* Vh = PROJ + (size_t)b * SEQ * LDP + C_AV + h * 128;
  const int sr = tid >> 4, sc = (tid & 15) * 8, vst0 = v_st(sr, sc), vst1 = v_st(32 + sr, sc);
  const int vb0 = (int)(uintptr_t)V_lds + v_rd_base(lane);
  const int cw = 4 * u + (wid >> 1), kc_lo = (4 * u - 8 > 0) ? 4 * u - 8 : 0, NT = 4 * u + 3 - kc_lo + 1;
  const int qloc = 32 * (wid & 1) + r32;
  bf16x8 vs0, vs1, ks0, ks1;
#define SLOAD(k0) do { vs0 = *(const GAS bf16x8*)(Vh + (size_t)((k0) + sr) * LDP + sc); vs1 = *(const GAS bf16x8*)(Vh + (size_t)((k0) + 32 + sr) * LDP + sc); \
    ks0 = *(const GAS bf16x8*)(Kh + (size_t)((k0) + sr) * LDP + sc); ks1 = *(const GAS bf16x8*)(Kh + (size_t)((k0) + 32 + sr) * LDP + sc); } while (0)
#define SWRITE(bb) do { *(LAS bf16x8*)(V_lds + (bb) * SHM_V + vst0) = vs0; *(LAS bf16x8*)(V_lds + (bb) * SHM_V + vst1) = vs1; const int kc_ = sc * 2; \
    *(LAS bf16x8*)(K_lds + (bb) * SHM_K + KSWZ(sr, kc_)) = ks0; *(LAS bf16x8*)(K_lds + (bb) * SHM_K + KSWZ(32 + sr, kc_)) = ks1; } while (0)
  SLOAD(kc_lo * 64); SWRITE(0); __syncthreads();
  for (int j = 0; j < NT; ++j) {
    const int kc = kc_lo + j, buf = j & 1;
    if (j + 1 < NT) SLOAD((kc + 1) * 64);
    if (kc >= cw - 8 && kc <= cw) {
      f32x16 p0, p1; float alpha; bf16x8 pa0, pa1, pa2, pa3;
      qkt(p0, p1, K_lds + buf * SHM_K, qr, r32, hi);
      const int delta = cw - kc;
      if (delta <= 2) {
        const int base = delta * 64 + qloc + 128;
#pragma unroll
        for (int r = 0; r < 16; ++r) { const int i0 = base - crow(r, hi), i1 = i0 - 32;
          p0[r] += bl[i0 > 256 ? 256 : i0]; p1[r] += bl[i1 > 256 ? 256 : i1]; }
      }
      partialSM(p0, p1, m_reg, alpha);
      if (__any(alpha < 1.f)) { if (hi == 0) al_l[r32] = alpha; asm volatile("s_waitcnt lgkmcnt(0)" ::: "memory");
#pragma unroll
        for (int d = 0; d < 4; ++d)
#pragma unroll
          for (int r = 0; r < 16; ++r) o[d][r] *= al_l[crow(r, hi)]; }
      finishSM(p0, p1, alpha, l_reg, pa0, pa1, pa2, pa3); SBAR();
      pv_d0(o, vb0 + buf * SHM_V, pa0, pa1, pa2, pa3);
    }
    if (j + 1 < NT) SWRITE(buf ^ 1);
    __syncthreads();
  }
#undef SLOAD
#undef SWRITE
  if (hi == 0) li_l[r32] = l_reg; asm volatile("s_waitcnt lgkmcnt(0)" ::: "memory");
  float rli[16];
#pragma unroll
  for (int r = 0; r < 16; ++r) rli[r] = __builtin_amdgcn_rcpf(li_l[crow(r, hi)]);
#pragma unroll
  for (int r = 0; r < 16; ++r) { const size_t row = mrow0 + wid * 32 + crow(r, hi);
#pragma unroll
    for (int d0 = 0; d0 < 4; ++d0) { const float gz = bf2f(PROJ[row * LDP + C_AZ + h * 128 + d0 * 32 + r32]);
      MIX[row * DM + h * 128 + d0 * 32 + r32] = (bf16)f2bf(o[d0][r] * rli[r] * gz); } }
  __syncthreads();
}
#undef KSWZ
#undef SBAR
}

struct Args { const float* in[12]; float* out; unsigned char* ws; int ph_lo, ph_hi, li, pad; };
__global__ void __launch_bounds__(NWAVES * 64, 2) hymba_fwd(Args args) {
    extern __shared__ __attribute__((aligned(16))) unsigned char lds[];
    Frame F;
    F.lds = (LAS unsigned char*)lds;
    F.MISC = (volatile LAS unsigned*)(F.lds + MISC_OFF);
    F.tid = threadIdx.x; F.lane = F.tid & 63; F.wave = __builtin_amdgcn_readfirstlane(F.tid >> 6);
    F.G = gridDim.x; { const int bx = blockIdx.x; F.vcu = (F.G % 8 == 0) ? (bx % 8) * (F.G / 8) + bx / 8 : bx; }
    unsigned char* ws = args.ws;
    F.ctl = (gu32*)(ws + WS_CTL);
    F.x = args.in[0]; F.c = args.in[1]; F.norm_g = args.in[2]; F.w_ada = args.in[3]; F.b_ada = args.in[4]; F.w_in = args.in[5];
    F.q_g = args.in[6]; F.k_g = args.in[7]; F.rel_bias = args.in[8]; F.lower_bounds = args.in[9]; F.hg_g = args.in[10]; F.w_out = args.in[11];
    F.out = args.out; F.mod = (float*)(ws + WS_CTL) + CW_MOD;
    F.WIN = (bf16*)(ws + WS_WIN); F.WOUT = (bf16*)(ws + WS_WOUT); F.HB = (bf16*)(ws + WS_H); F.MIX = (bf16*)(ws + WS_MIX);
    F.PROJ = (bf16*)(ws + WS_PROJ); F.UT = (bf16*)(ws + WS_UT); F.DL = (float*)(ws + WS_DL);
    for (int u = F.tid; u < (LDS_BYTES - LDSCTL_OFF) / 4; u += NWAVES * 64) ((LAS unsigned*)(F.lds + LDSCTL_OFF))[u] = 0u;
    __syncthreads();
    XcdBarrier bar; bar.bar = (unsigned*)(F.ctl + CW_BAR); bar.x = 0; bar.st = nullptr;
    if (N_LAUNCHES == 1) bar = xcd_barrier_post((unsigned*)(F.ctl + CW_BAR), F.MISC + 8);
#define GRID_BAR() do { if (N_LAUNCHES == 1) xcd_barrier(bar); } while (0)
    const int lo = args.ph_lo, hi = args.ph_hi;
#define IN(k) (lo <= (k) && (k) < hi)
#define BOTH(k) (IN(k) && IN((k) + 1))

    if (IN(0)) { p0_prologue(F); if (BOTH(0)) GRID_BAR(); }
    if (IN(1)) { p1_rows(F); if (BOTH(1)) GRID_BAR(); }
    if (IN(2)) {
        pg8::Gemm g{F.HB, F.WIN, MROWS, NIN, DM}; pg8::StaticOrder S; S.init(MROWS, NIN, F.G, (int)blockIdx.x);
        pg8::EpiProj E{F.PROJ, LDP};
        pg8::gemm_phase<pg8::EpiProj, pg8::StaticOrder, true, true>(F.lds + RING_OFF, g, S, E);
        if (BOTH(2)) GRID_BAR();
    }
    if (IN(3)) {
        for (int it = F.vcu; it < BATCH * NCH * NH; it += F.G) hg_prep_item(F, it);
        p3_qknorm(F);
        if (BOTH(3)) GRID_BAR();
    }
    if (IN(4)) {
        for (int i = F.vcu; i < BATCH * NH * 8; i += F.G) {
            const int bh = i >> 3, u = i & 7;
            if (u == 0) hg_scan(F, bh);
            att::attn_unit(bh >> 3, bh & 7, u, F.PROJ, F.MIX, F.rel_bias, F.lds);
        }
        if (BOTH(4)) GRID_BAR();
    }
    if (IN(5)) {
        pg8::Gemm g{F.MIX, F.WOUT, MROWS, DM, DM}; pg8::StaticOrder S; S.init(MROWS, DM, F.G, (int)blockIdx.x);
        pg8::EpiOut E{F.x, F.out, F.mod + 2 * DM};
        pg8::gemm_phase<pg8::EpiOut, pg8::StaticOrder, true, true>(F.lds + RING_OFF, g, S, E);
    }
#undef IN
#undef BOTH
#undef GRID_BAR
}

extern "C" void kernel_launch(void* const* d_in, const int* in_sizes, int n_in, void* d_out, int out_size, void* d_ws, size_t ws_size, hipStream_t stream) {
    static int grid = 0;
    if (grid == 0) {
        if (n_in != 12 || in_sizes[0] != MROWS * DM || out_size != MROWS * DM || ws_size < WS_END) {
            fprintf(stderr, "kernel_launch: shape mismatch: n_in %d in0 %d out %d ws %zu (need %zu)\n", n_in, n_in > 0 ? in_sizes[0] : -1, out_size, ws_size, (size_t)WS_END); grid = -1; return; }
        int dev = 0, cus = 0, per_cu = 0;
        if (hipGetDevice(&dev) != hipSuccess || hipDeviceGetAttribute(&cus, hipDeviceAttributeMultiprocessorCount, dev) != hipSuccess) { fprintf(stderr, "kernel_launch: device query failed\n"); grid = -1; return; }
        if (hipFuncSetAttribute((const void*)hymba_fwd, hipFuncAttributeMaxDynamicSharedMemorySize, LDS_BYTES) != hipSuccess) { fprintf(stderr, "kernel_launch: hipFuncSetAttribute failed\n"); grid = -1; return; }
        if (hipOccupancyMaxActiveBlocksPerMultiprocessor(&per_cu, (const void*)hymba_fwd, NWAVES * 64, LDS_BYTES) != hipSuccess || per_cu < 1) {
            fprintf(stderr, "kernel_launch: occupancy query reports %d workgroups per CU; not launching\n", per_cu); (void)hipGetLastError(); grid = -1; return; }
        grid = cus;
        if (grid % 8 != 0 || grid > 256) grid = (grid > 256) ? 256 : (grid / 8) * 8;
    }
    if (grid <= 0) return;
    if (hipMemsetAsync((char*)d_ws + WS_CTL, 0, CTL_ZERO_BYTES, stream) != hipSuccess) { fprintf(stderr, "kernel_launch: memset failed\n"); return; }
    Args a{};
    for (int i = 0; i < 12; ++i) a.in[i] = (const float*)d_in[i];
    a.out = (float*)d_out; a.ws = (unsigned char*)d_ws;
    if (N_LAUNCHES == 1) {
        a.ph_lo = 0; a.ph_hi = PER_PHASE; a.li = 0;
        void* kargs[] = {&a};
        hipError_t e = hipLaunchCooperativeKernel((const void*)hymba_fwd, dim3(grid), dim3(NWAVES * 64), kargs, LDS_BYTES, stream);
        if (e != hipSuccess) fprintf(stderr, "kernel_launch: cooperative launch failed: %s (grid %d)\n", hipGetErrorString(e), grid);
    } else {
        for (int li = 0; li < PER_PHASE; ++li) {
            a.ph_lo = li; a.ph_hi = li + 1; a.li = li;
            hipLaunchKernelGGL(hymba_fwd, dim3(grid), dim3(NWAVES * 64), LDS_BYTES, stream, a);
            const hipError_t le = hipPeekAtLastError();
            if (le != hipSuccess) { fprintf(stderr, "kernel_launch: launch %d failed: %s\n", li, hipGetErrorName(le)); break; }
        }
    }
}
```

```cpp
#include <hip/hip_runtime.h>
#include <cstdio>
#include <cstdint>

#ifndef MK_N_LAUNCHES
#define MK_N_LAUNCHES 1
#endif
#ifndef REP0T
#define REP0T 1
#endif
#ifndef REP1
#define REP1 1
#endif
#ifndef REP2
#define REP2 1
#endif
#ifndef REP4S
#define REP4S 1
#endif
#ifndef REP4A
#define REP4A 1
#endif
#ifndef REP5
#define REP5 1
#endif
namespace pg8 {
#define PG8_LAS __attribute__((address_space(3)))
typedef unsigned short bf16_t;
typedef short bf16x8 __attribute__((ext_vector_type(8)));
typedef float f32x4 __attribute__((ext_vector_type(4)));
typedef unsigned u32x4 __attribute__((ext_vector_type(4)));
constexpr int BM = 256, BK = 64, HALF = 128, HTB = HALF * BK * 2  , STAGE_BYTES = 8 * HTB, NXCD = 8, WGM = 8;

__host__ __device__ __forceinline__ int lds_byte(int r, int c) { const int st = (r >> 4) * 2 + (c >> 5), rr = r & 15, cc = c & 31, ob = rr * 64 + cc * 2; return st * 1024 + (ob ^ (((ob >> 9) & 1) << 5)); }
__host__ __device__ __forceinline__ void stage_rc(int b, int& R, int& C) { const int st = b / 1024, sb = b % 1024, swz = sb ^ (((sb >> 9) & 1) << 5); R = (st >> 1) * 16 + swz / 64; C = (st & 1) * 32 + (swz % 64) / 2; }
__host__ __device__ __forceinline__ int perm32(int rho) { const int n = rho >> 4, i = rho & 15; return 8 * (i >> 2) + 4 * n + (i & 3); }

struct Unit { int pm, pn; };
struct Gemm { const bf16_t* A; const bf16_t* Bt; int M, N, K; };

struct StaticOrder {
    int nM, nN, nwg, G, c;
    __host__ __device__ void init(int M, int N, int G_, int c_) { nM = M / BM; nN = N / BM; nwg = nM * nN; G = G_; c = c_; }
    __host__ __device__ bool next(int i, Unit& u) const {
        const long L = (long)i * G + c; if (L >= nwg) return false;
        int wgid = (int)L; { const int q = nwg / NXCD, r = nwg % NXCD, xcd = wgid % NXCD, off = wgid / NXCD; wgid = (xcd < r ? xcd * (q + 1) : r * (q + 1) + (xcd - r) * q) + off; }
        const int nig = WGM * nN, gid = wgid / nig, fm = gid * WGM, gsz = (nM - fm) < WGM ? (nM - fm) : WGM;
        u.pm = fm + ((wgid % nig) % gsz); u.pn = (wgid % nig) / gsz; return true;
    }
    __device__ __forceinline__ void a_ready(const Unit&) const {}
    __device__ __forceinline__ void done(const Unit&) const {}
};

__device__ __forceinline__ unsigned cvt_pk_bf16(float lo, float hi) { unsigned r; asm volatile("v_cvt_pk_bf16_f32 %0, %1, %2" : "=v"(r) : "v"(lo), "v"(hi)); return r; }
__device__ __forceinline__ float silu_f(float v) { return v * __builtin_amdgcn_rcpf(1.0f + __builtin_amdgcn_exp2f(-1.4426950408889634f * v)); }
struct EpiProj {
    static constexpr bool PERM = true, AFTER_DRAIN = false;
    bf16_t* O; int ldc;
    __device__ __forceinline__ void operator()(const f32x4 (&acc)[2][2][4][2], const Unit& u, int wr, int wc, int fr, int fq) const {
        const int row0 = u.pm * BM + wr * 64 + fr, col0 = u.pn * BM + wc * 32 + 8 * fq;
        const int grp = u.pn >> 2; const bool act = (grp == 3) || (grp == 4) || (grp == 7);
#pragma unroll
        for (int ai = 0; ai < 2; ++ai)
#pragma unroll
            for (int m = 0; m < 4; ++m) { bf16_t* rowp = O + (size_t)(row0 + ai * HALF + m * 16) * ldc + col0;
#pragma unroll
                for (int bj = 0; bj < 2; ++bj) { f32x4 v0 = acc[ai][bj][m][0], v1 = acc[ai][bj][m][1];
                    if (act) {
#pragma unroll
                        for (int i = 0; i < 4; ++i) { v0[i] = silu_f(v0[i]); v1[i] = silu_f(v1[i]); } }
                    u32x4 w; w.x = cvt_pk_bf16(v0[0], v0[1]); w.y = cvt_pk_bf16(v0[2], v0[3]); w.z = cvt_pk_bf16(v1[0], v1[1]); w.w = cvt_pk_bf16(v1[2], v1[3]);
                    *(u32x4*)(rowp + bj * HALF) = w; } }
    }
};
struct EpiOut {
    static constexpr bool PERM = false, AFTER_DRAIN = false;
    const float* x; float* out; const float* gate;
    __device__ __forceinline__ void operator()(const f32x4 (&acc)[2][2][4][2], const Unit& u, int wr, int wc, int fr, int fq) const {
        const int row0 = u.pm * BM + wr * 64 + fr, col0 = u.pn * BM + wc * 32 + 4 * fq;
        const float* gp = gate + (size_t)(u.pm >> 3) * 6144 + col0;
        f32x4 gv[2][2];
#pragma unroll
        for (int bj = 0; bj < 2; ++bj)
#pragma unroll
            for (int n = 0; n < 2; ++n) gv[bj][n] = *(const f32x4*)(gp + bj * HALF + n * 16);
#pragma unroll
        for (int ai = 0; ai < 2; ++ai)
#pragma unroll
            for (int m = 0; m < 4; ++m) { const size_t off = (size_t)(row0 + ai * HALF + m * 16) * 2048 + col0;
#pragma unroll
                for (int bj = 0; bj < 2; ++bj)
#pragma unroll
                    for (int n = 0; n < 2; ++n) { const f32x4 xv = *(const f32x4*)(x + off + bj * HALF + n * 16);
                        *(f32x4*)(out + off + bj * HALF + n * 16) = xv + gv[bj][n] * acc[ai][bj][m][n]; } }
    }
};

template <class Epi, class Sched, bool ALIGN_EPI = false, bool SP2 = false>
__device__ __forceinline__ void gemm_phase(PG8_LAS unsigned char* lds, const Gemm g, const Sched& S, const Epi& E) {
    const int tid = threadIdx.x, wid = __builtin_amdgcn_readfirstlane(tid >> 6), lane = tid & 63, wr = wid >> 2, wc = wid & 3, fr = lane & 15, fq = lane >> 4;
    const int K = g.K, nt = K / BK;
    unsigned voffA[2], voffB[2];
#pragma unroll
    for (int i = 0; i < 2; ++i) { int R, C; stage_rc(tid * 16 + i * 8192, R, C); const int Rb = Epi::PERM ? ((R & ~31) + perm32(R & 31)) : R;
        voffA[i] = (unsigned)(R * K + C) * 2u; voffB[i] = (unsigned)(Rb * K + C) * 2u; }
    const size_t kstep = (size_t)(BK * 2);
    const size_t hstep = (size_t)HALF * K * 2;
    const size_t tstep = 2 * hstep;
    const unsigned ldsw = (unsigned)wid * 1024u;
    const int aoff = lds_byte(wr * 64 + fr, fq * 8), boff = lds_byte(wc * 32 + fr, fq * 8);
#define PG8_SA(b, h) (((b) * 2 + (h)) * HTB)
#define PG8_SB(b, h) ((4 + (b) * 2 + (h)) * HTB)
#define PG8_STAGE(bufoff, gbase, voff) do { _Pragma("unroll") for (int _i = 0; _i < 2; ++_i) \
        __builtin_amdgcn_global_load_lds((const unsigned*)((const char*)(gbase) + (voff)[_i]), (PG8_LAS unsigned*)(lds + (bufoff) + ldsw + _i * 8192), 16, 0, 0); } while (0)
#define PG8_LDA(dst, b, h) do { _Pragma("unroll") for (int m = 0; m < 4; ++m) _Pragma("unroll") for (int k = 0; k < 2; ++k) dst[m][k] = *(const PG8_LAS bf16x8*)(lds + PG8_SA(b, h) + aoff + m * 2048 + k * 1024); } while (0)
#define PG8_LDB(dst, b, h) do { _Pragma("unroll") for (int n = 0; n < 2; ++n) _Pragma("unroll") for (int k = 0; k < 2; ++k) dst[n][k] = *(const PG8_LAS bf16x8*)(lds + PG8_SB(b, h) + boff + n * 2048 + k * 1024); } while (0)
#define PG8_MMA(ai, bj, At, Bt) do { __builtin_amdgcn_s_setprio(1); _Pragma("unroll") for (int m = 0; m < 4; ++m) _Pragma("unroll") for (int n = 0; n < 2; ++n) _Pragma("unroll") for (int k = 0; k < 2; ++k) \
        acc[ai][bj][m][n] = __builtin_amdgcn_mfma_f32_16x16x32_bf16(Bt[n][k], At[m][k], acc[ai][bj][m][n], 0, 0, 0); __builtin_amdgcn_s_setprio(0); } while (0)
#define PG8_WAIT_V(n) asm volatile("s_waitcnt vmcnt(" #n ")" ::: "memory")
#define PG8_WAIT_L(n) asm volatile("s_waitcnt lgkmcnt(" #n ")" ::: "memory")
#define PG8_BAR __builtin_amdgcn_s_barrier()
#define PG8_SCHED __builtin_amdgcn_sched_barrier(0)
    Unit cur, nxt; int ui = 0;
    if (!S.next(0, cur)) return;
    f32x4 acc[2][2][4][2];
#pragma unroll
    for (int a = 0; a < 2; ++a)
#pragma unroll
        for (int b = 0; b < 2; ++b)
#pragma unroll
            for (int m = 0; m < 4; ++m)
#pragma unroll
                for (int n = 0; n < 2; ++n) acc[a][b][m][n] = (f32x4){0.f, 0.f, 0.f, 0.f};
    bf16x8 At[4][2], B0[2][2], B1[2][2];
    const char* cA = (const char*)g.A + (size_t)cur.pm * tstep; const char* cB = (const char*)g.Bt + (size_t)cur.pn * tstep;
    S.a_ready(cur);
    if constexpr (SP2) {
        PG8_STAGE(PG8_SB(0, 0), cB, voffB); PG8_STAGE(PG8_SB(0, 1), cB + hstep, voffB); PG8_STAGE(PG8_SA(0, 0), cA, voffA); PG8_STAGE(PG8_SA(0, 1), cA + hstep, voffA);
        if (wr == 1) PG8_BAR;
        PG8_WAIT_V(2); PG8_BAR;
        PG8_STAGE(PG8_SB(1, 0), cB + kstep, voffB); PG8_STAGE(PG8_SA(1, 0), cA + kstep, voffA); PG8_STAGE(PG8_SB(1, 1), cB + hstep + kstep, voffB);
        PG8_WAIT_V(6); PG8_BAR;
    } else {
        PG8_STAGE(PG8_SB(0, 0), cB, voffB); PG8_STAGE(PG8_SA(0, 0), cA, voffA); PG8_STAGE(PG8_SB(0, 1), cB + hstep, voffB); PG8_STAGE(PG8_SA(0, 1), cA + hstep, voffA);
        if (wr == 1) PG8_BAR;
        PG8_WAIT_V(4); PG8_BAR;
        PG8_STAGE(PG8_SB(1, 0), cB + kstep, voffB); PG8_STAGE(PG8_SA(1, 0), cA + kstep, voffA); PG8_STAGE(PG8_SB(1, 1), cB + hstep + kstep, voffB);
        PG8_WAIT_V(6); PG8_BAR;
    }
    for (;;) {
        const bool has_next = S.next(ui + 1, nxt);
        const char* nA = has_next ? (const char*)g.A + (size_t)nxt.pm * tstep : cA; const char* nB = has_next ? (const char*)g.Bt + (size_t)nxt.pn * tstep : cB;
        for (int t = 0; t < nt; t += 2) {
            const bool last = (t == nt - 2);
            const char* a1 = cA + (size_t)(t + 1) * kstep;
            const char* a2 = last ? nA : cA + (size_t)(t + 2) * kstep; const char* b2 = last ? nB : cB + (size_t)(t + 2) * kstep;
            const char* a3 = a2 + kstep; const char* b3 = b2 + kstep;
            if (last && has_next) S.a_ready(nxt);
            if constexpr (SP2) {
            PG8_LDB(B0, 0, 0); PG8_LDB(B1, 0, 1); PG8_SCHED; PG8_LDA(At, 0, 0); PG8_STAGE(PG8_SA(1, 1), a1 + hstep, voffA);
            PG8_WAIT_V(8); PG8_WAIT_L(0); PG8_BAR; PG8_MMA(0, 0, At, B0); PG8_MMA(0, 1, At, B1); PG8_BAR; PG8_SCHED;
            PG8_LDA(At, 0, 1); PG8_STAGE(PG8_SB(0, 0), b2, voffB); PG8_STAGE(PG8_SB(0, 1), b2 + hstep, voffB); PG8_STAGE(PG8_SA(0, 0), a2, voffA);
            PG8_WAIT_V(8); PG8_WAIT_L(0); PG8_BAR; PG8_MMA(1, 0, At, B0); PG8_MMA(1, 1, At, B1); PG8_BAR; PG8_SCHED;
            PG8_LDB(B0, 1, 0); PG8_LDB(B1, 1, 1); PG8_SCHED; PG8_LDA(At, 1, 0); PG8_STAGE(PG8_SA(0, 1), a2 + hstep, voffA);
            PG8_WAIT_V(8); PG8_WAIT_L(0); PG8_BAR; PG8_MMA(0, 0, At, B0); PG8_MMA(0, 1, At, B1); PG8_BAR; PG8_SCHED;
            PG8_LDA(At, 1, 1); PG8_STAGE(PG8_SB(1, 0), b3, voffB); PG8_STAGE(PG8_SB(1, 1), b3 + hstep, voffB); PG8_STAGE(PG8_SA(1, 0), a3, voffA);
            PG8_WAIT_V(8); PG8_WAIT_L(0); PG8_BAR; PG8_MMA(1, 0, At, B0); PG8_MMA(1, 1, At, B1); PG8_BAR; PG8_SCHED;
            } else {
            PG8_LDB(B0, 0, 0); PG8_SCHED; PG8_LDA(At, 0, 0); PG8_STAGE(PG8_SA(1, 1), a1 + hstep, voffA);
            PG8_WAIT_L(8); PG8_BAR; PG8_WAIT_L(0); PG8_MMA(0, 0, At, B0); PG8_BAR; PG8_SCHED;
            PG8_LDB(B1, 0, 1); PG8_STAGE(PG8_SB(0, 0), b2, voffB);
            PG8_BAR; PG8_WAIT_L(0); PG8_MMA(0, 1, At, B1); PG8_BAR;
            PG8_LDA(At, 0, 1); PG8_STAGE(PG8_SA(0, 0), a2, voffA);
            PG8_BAR; PG8_WAIT_L(0); PG8_MMA(1, 0, At, B0); PG8_BAR; PG8_SCHED;
            PG8_STAGE(PG8_SB(0, 1), b2 + hstep, voffB);
            PG8_WAIT_V(6); PG8_BAR; PG8_MMA(1, 1, At, B1); PG8_BAR;
            PG8_LDB(B0, 1, 0); PG8_SCHED; PG8_LDA(At, 1, 0); PG8_STAGE(PG8_SA(0, 1), a2 + hstep, voffA);
            PG8_WAIT_L(8); PG8_BAR; PG8_WAIT_L(0); PG8_MMA(0, 0, At, B0); PG8_BAR; PG8_SCHED;
            PG8_LDB(B1, 1, 1); PG8_STAGE(PG8_SB(1, 0), b3, voffB);
            PG8_BAR; PG8_WAIT_L(0); PG8_MMA(0, 1, At, B1); PG8_BAR;
            PG8_LDA(At, 1, 1); PG8_STAGE(PG8_SA(1, 0), a3, voffA);
            PG8_BAR; PG8_WAIT_L(0); PG8_MMA(1, 0, At, B0); PG8_BAR; PG8_SCHED;
            PG8_STAGE(PG8_SB(1, 1), b3 + hstep, voffB);
            PG8_WAIT_V(6); PG8_BAR; PG8_MMA(1, 1, At, B1); PG8_BAR;
            }
        }
        if constexpr (ALIGN_EPI) { if (wr == 0) PG8_BAR; }
        if constexpr (!Epi::AFTER_DRAIN) { E(acc, cur, wr, wc, fr, fq); S.done(cur); }
        if (!has_next) break;
#pragma unroll
        for (int a = 0; a < 2; ++a)
#pragma unroll
            for (int b = 0; b < 2; ++b)
#pragma unroll
                for (int m = 0; m < 4; ++m)
#pragma unroll
                    for (int n = 0; n < 2; ++n) acc[a][b][m][n] = (f32x4){0.f, 0.f, 0.f, 0.f};
        cur = nxt; cA = nA; cB = nB; ++ui;
        if constexpr (ALIGN_EPI) { if (wr == 1) PG8_BAR; }
    }
    PG8_WAIT_V(0);
    if constexpr (!ALIGN_EPI) { if (wr == 0) PG8_BAR; }
    PG8_BAR;
    if constexpr (Epi::AFTER_DRAIN) { E.fused(acc, cur, wr, wc, fr, fq, lds, wid, lane); S.done(cur); }
#undef PG8_SA
#undef PG8_SB
#undef PG8_STAGE
#undef PG8_LDA
#undef PG8_LDB
#undef PG8_MMA
#undef PG8_WAIT_V
#undef PG8_WAIT_L
#undef PG8_BAR
#undef PG8_SCHED
}
}

constexpr int NWAVES = 8;
constexpr int N_LAUNCHES = MK_N_LAUNCHES;
constexpr int PER_PHASE = 7;
constexpr int DM = 2048, BATCH = 4, SEQ = 2048, MROWS = BATCH * SEQ, NIN = 8192, CHUNK = 64, NCH = SEQ / CHUNK, NH = 8, DH = 128;
constexpr int LDP = NIN;
constexpr int C_AQ = 0, C_AK = 1024, C_AV = 2048, C_AZ = 3072, C_GQ = 4096, C_GF = 5120, C_GI = 6144, C_GZ = 7168;
constexpr float EPS = 1e-6f, LOG2E = 1.4426950408889634f;

constexpr size_t MiB = 1u << 20;
constexpr size_t WS_CTL = 0, CTL_ZERO_BYTES = 1 * MiB;
constexpr size_t WS_WIN = 2 * MiB;
constexpr size_t WS_UT = 2 * MiB;
constexpr size_t WS_WOUT = 34 * MiB;
constexpr size_t WS_H = 42 * MiB;
constexpr size_t WS_MIX = 42 * MiB;
constexpr size_t WS_PROJ = 74 * MiB;
constexpr size_t WS_DL = 202 * MiB;
constexpr size_t WS_SALL = 203 * MiB;
constexpr size_t WS_END = 235 * MiB;
constexpr int CW_BAR = 4096;
constexpr int CW_MOD = 131072;
static_assert((CW_MOD + 4 * 6144) * 4 <= (int)CTL_ZERO_BYTES, "ctl map");

constexpr int RING_OFF = 0, RING_BYTES = 131072;
constexpr int LDSCTL_OFF = RING_BYTES, MISC_OFF = LDSCTL_OFF + 320;
constexpr int LDS_BYTES = 147456;

#define GAS __attribute__((address_space(1)))
#define LAS __attribute__((address_space(3)))
typedef unsigned short bf16;
typedef unsigned v4u __attribute__((ext_vector_type(4)));
typedef unsigned v2u __attribute__((ext_vector_type(2)));
typedef float f32x4 __attribute__((ext_vector_type(4)));
typedef float f32x16 __attribute__((ext_vector_type(16)));
typedef short bf16x8 __attribute__((ext_vector_type(8)));
typedef short s16x4 __attribute__((ext_vector_type(4)));
typedef GAS unsigned gu32;
#define RLX_AGENT __ATOMIC_RELAXED, __HIP_MEMORY_SCOPE_AGENT
#define LDS_WAIT() asm volatile("s_waitcnt lgkmcnt(0)" ::: "memory")
#define VM_WAIT() asm volatile("s_waitcnt vmcnt(0)" ::: "memory")
__device__ __forceinline__ unsigned f2bf(float f) { unsigned u = __builtin_bit_cast(unsigned, f); return (u + 0x7fffu + ((u >> 16) & 1u)) >> 16; }
__device__ __forceinline__ unsigned pk2(float lo, float hi) { return f2bf(lo) | (f2bf(hi) << 16); }
__device__ __forceinline__ float bf2f(unsigned short h) { return __builtin_bit_cast(float, (unsigned)h << 16); }
__device__ __forceinline__ float bflo(unsigned w) { return __builtin_bit_cast(float, w << 16); }
__device__ __forceinline__ float bfhi(unsigned w) { return __builtin_bit_cast(float, w & 0xffff0000u); }
__device__ __forceinline__ float fexp(float x) { return __builtin_amdgcn_exp2f(x * LOG2E); }
__device__ __forceinline__ float silu1(float v) { return v * __builtin_amdgcn_rcpf(1.0f + __builtin_amdgcn_exp2f(-LOG2E * v)); }

#define XB_TMO      128
#define XB_XCNT(j)  (256  + 64 * (j))
#define XB_XSUB(j)  (1280 + 64 * (j))
#define XB_XGEN(j)  (2304 + 64 * (j))
#define XB_TOP      3328
#define XB_TOPGEN   3392
#define XCD_BAR_WORDS 3456
#define XB_SPIN_CAP (1u << 18)

__device__ __forceinline__ unsigned xb_ld(unsigned* p)              { return __hip_atomic_load(p, __ATOMIC_RELAXED, __HIP_MEMORY_SCOPE_AGENT); }
__device__ __forceinline__ unsigned xb_add(unsigned* p, unsigned v) { return __hip_atomic_fetch_add(p, v, __ATOMIC_RELAXED, __HIP_MEMORY_SCOPE_AGENT); }
__device__ __forceinline__ unsigned xb_xcc_id() { return (unsigned)__builtin_amdgcn_s_getreg((3 << 11) | 20) & 0xFu; }
#define XB_SPIN(cond, bar) do { unsigned _sp = 0; while (cond) { __builtin_amdgcn_s_sleep(1); \
    if ((++_sp & 255u) == 0u) { if (xb_ld(&(bar)[XB_TMO])) break; if (_sp > XB_SPIN_CAP) { atomicAdd(&(bar)[XB_TMO], 1u); break; } } } } while (0)

struct XcdBarrier {
    unsigned* bar; unsigned x;
    volatile LAS unsigned* st;
};

__device__ __forceinline__ XcdBarrier xcd_barrier_post(unsigned* bar, volatile LAS unsigned* st) {
    XcdBarrier b; b.bar = bar; b.x = xb_xcc_id(); b.st = st;
    if (threadIdx.x == 0) (void)xb_add(&bar[XB_XCNT(b.x)], 1u);
    return b;
}
__device__ __forceinline__ void xcd_barrier_complete(unsigned* bar, unsigned x, unsigned& nloc, unsigned& nx) {
    const unsigned G = gridDim.x * gridDim.y * gridDim.z;
    unsigned sum, cnt, mine, sp = 0u;
    for (;;) {
        sum = 0u; cnt = 0u; mine = 0u;
#pragma unroll
        for (unsigned j = 0; j < 16; ++j) { const unsigned c = xb_ld(&bar[XB_XCNT(j)]); sum += c; cnt += (c > 0u) ? 1u : 0u; mine = (j == x) ? c : mine; }
        if (sum == G) break;
        __builtin_amdgcn_s_sleep(1);
        if ((++sp & 255u) == 0u) { if (xb_ld(&bar[XB_TMO])) break; if (sp > XB_SPIN_CAP) { atomicAdd(&bar[XB_TMO], 1u); break; } }
    }
    nloc = mine > 0u ? mine : 1u; nx = cnt > 0u ? cnt : 1u;
}

__device__ __forceinline__ void xcd_barrier(const XcdBarrier& b) {
    asm volatile("s_waitcnt vmcnt(0)" ::: "memory");
    __syncthreads();
    if (threadIdx.x == 0) {
        unsigned* bar = b.bar;
        __builtin_amdgcn_s_waitcnt(0);
        unsigned nloc = b.st[0], nx = b.st[1];
        if (nloc == 0u) { xcd_barrier_complete(bar, b.x, nloc, nx); b.st[0] = nloc; b.st[1] = nx; }
        const unsigned old = xb_add(&bar[XB_XSUB(b.x)], 1u);
        const unsigned gen = old / nloc;
        if (old + 1u == (gen + 1u) * nloc) {
            __builtin_amdgcn_fence(__ATOMIC_RELEASE, "agent");
            asm volatile("s_waitcnt vmcnt(0)" ::: "memory");
            const unsigned og = xb_add(&bar[XB_TOP], 1u);
            const unsigned tg = og / nx;
            if (og + 1u == (tg + 1u) * nx) xb_add(&bar[XB_TOPGEN], 1u);
            else XB_SPIN(xb_ld(&bar[XB_TOPGEN]) == tg, bar);
            __builtin_amdgcn_fence(__ATOMIC_ACQUIRE, "agent");
            xb_add(&bar[XB_XGEN(b.x)], 1u);
            asm volatile("s_waitcnt vmcnt(0)" ::: "memory");
        } else {
            XB_SPIN(xb_ld(&bar[XB_XGEN(b.x)]) == gen, bar);
            __builtin_amdgcn_fence(__ATOMIC_ACQUIRE, "agent");
            asm volatile("s_waitcnt vmcnt(0)" ::: "memory");
        }
    }
    __syncthreads();
}

struct Frame {
    LAS unsigned char* lds;
    volatile LAS unsigned* MISC;
    gu32* ctl;
    int tid, lane, wave;
    int vcu, G;
    const float *x, *c, *norm_g, *w_ada, *b_ada, *w_in, *q_g, *k_g, *rel_bias, *lower_bounds, *hg_g, *w_out;
    float* out;
    float* mod;
    bf16 *WIN, *WOUT, *HB, *MIX, *PROJ, *UT, *SALL; float* DL;
};

__device__ __forceinline__ float wave_sum(float v) {
#pragma unroll
    for (int o = 1; o < 64; o <<= 1) v += __shfl_xor(v, o);
    return v;
}
__device__ __forceinline__ void p0_transpose_item(const float* W, int K, int N, bf16* WT, LAS float* scr, int item, int lane) {
    const int nblk = N / 32, kb = item / nblk, nb = item % nblk, k0 = 64 * kb, n0 = 32 * nb;
#pragma unroll 8
    for (int i = 0; i < 32; ++i) { const int kk = 2 * i + (lane >> 5); scr[kk * 33 + (lane & 31)] = W[(size_t)(k0 + kk) * N + n0 + (lane & 31)]; }
    LDS_WAIT(); asm volatile("" ::: "memory");
    const int c = lane & 7;
#pragma unroll
    for (int j = 0; j < 4; ++j) { const int n = (lane >> 3) + 8 * j; const LAS float* s = scr + (8 * c) * 33 + n;
        v4u o; o.x = pk2(s[0 * 33], s[1 * 33]); o.y = pk2(s[2 * 33], s[3 * 33]); o.z = pk2(s[4 * 33], s[5 * 33]); o.w = pk2(s[6 * 33], s[7 * 33]);
        *(GAS v4u*)(WT + (size_t)(n0 + n) * K + k0 + 8 * c) = o; }
    LDS_WAIT(); asm volatile("" ::: "memory");
}
__device__ __forceinline__ void p0_ada_item(Frame& F, int item) {
    const int kc = item / 24, cc = item % 24, k0 = 64 * kc, col = 256 * cc + 4 * F.lane;
    float ca[4];
#pragma unroll
    for (int b = 0; b < 4; ++b) ca[b] = silu1(F.c[b * DM + k0 + F.lane]);
    f32x4 acc[4];
#pragma unroll
    for (int b = 0; b < 4; ++b) acc[b] = (f32x4){0.f, 0.f, 0.f, 0.f};
    const GAS f32x4* wp = (const GAS f32x4*)(F.w_ada + (size_t)k0 * 6144 + col);
#pragma unroll 16
    for (int k = 0; k < 64; ++k) {
        const f32x4 w = wp[(size_t)k * (6144 / 4)];
#pragma unroll
        for (int b = 0; b < 4; ++b) { const float s = __shfl(ca[b], k); acc[b] += w * s; }
    }
    if (kc == 0) { const f32x4 bv = *(const f32x4*)(F.b_ada + col);
#pragma unroll
        for (int b = 0; b < 4; ++b) acc[b] += bv; }
#pragma unroll
    for (int b = 0; b < 4; ++b)
#pragma unroll
        for (int i = 0; i < 4; ++i) __hip_atomic_fetch_add(F.mod + b * 6144 + col + i, acc[b][i], RLX_AGENT);
}
__device__ __forceinline__ void p0_prologue(Frame& F) {
    LAS float* scr = (LAS float*)(F.lds + RING_OFF + F.wave * 16384);
    const int gw = F.vcu * NWAVES + F.wave, NGW = F.G * NWAVES;
    constexpr int I_ADA = 32 * 24, I_IN = (DM / 64) * (NIN / 32), I_OUT = (DM / 64) * (DM / 32);
    constexpr int NITEMS = I_ADA + I_IN + I_OUT;
    for (int rep = 0; rep < REP0T; ++rep)
    for (int it = gw; it < NITEMS; it += NGW) {
        int r = it;
        if (r < I_ADA) { if (rep == 0) p0_ada_item(F, r); continue; } r -= I_ADA;
        if (r < I_IN) { p0_transpose_item(F.w_in, DM, NIN, F.WIN, scr, r, F.lane); continue; } r -= I_IN;
        p0_transpose_item(F.w_out, DM, DM, F.WOUT, scr, r, F.lane);
    }
}
__device__ __forceinline__ void p1_rows(Frame& F) {
    const int gw = F.vcu * NWAVES + F.wave, NGW = F.G * NWAVES;
    for (int m = gw; m < MROWS; m += NGW) {
        const int b = m / SEQ;
        const GAS f32x4* xr = (const GAS f32x4*)(F.x + (size_t)m * DM) + F.lane;
        f32x4 v[8]; float s = 0.f;
#pragma unroll
        for (int j = 0; j < 8; ++j) { v[j] = xr[64 * j]; s += (v[j].x * v[j].x + v[j].y * v[j].y) + (v[j].z * v[j].z + v[j].w * v[j].w); }
        const float rinv = 1.0f / sqrtf(wave_sum(s) * (1.f / DM) + EPS);
        const GAS f32x4* gp = (const GAS f32x4*)F.norm_g + F.lane;
        const GAS f32x4* shp = (const GAS f32x4*)(F.mod + b * 6144) + F.lane;
        const GAS f32x4* scp = (const GAS f32x4*)(F.mod + b * 6144 + DM) + F.lane;
        GAS unsigned long long* o8 = (GAS unsigned long long*)(F.HB + (size_t)m * DM) + F.lane;
#pragma unroll
        for (int j = 0; j < 8; ++j) { const f32x4 g = gp[64 * j], sh = shp[64 * j], sc = scp[64 * j];
            const f32x4 hv = (v[j] * rinv) * g * (sc + 1.0f) + sh;
            o8[64 * j] = (unsigned long long)pk2(hv.x, hv.y) | ((unsigned long long)pk2(hv.z, hv.w) << 32); }
    }
}

__device__ __forceinline__ void p3_qknorm(Frame& F) {
    const int gw = F.vcu * NWAVES + F.wave, NGW = F.G * NWAVES;
    const int seg = F.lane >> 4, l16 = F.lane & 15;
    for (int it = gw; it < MROWS * 4; it += NGW) {
        const int m = it >> 2, g = it & 3;
        const int col = (g * 4 + seg) * 128 + l16 * 8;
        bf16* p = F.PROJ + (size_t)m * LDP + col;
        const v4u w = *(const GAS v4u*)p;
        float v[8] = {bflo(w.x), bfhi(w.x), bflo(w.y), bfhi(w.y), bflo(w.z), bfhi(w.z), bflo(w.w), bfhi(w.w)};
        float ss = 0.f;
#pragma unroll
        for (int i = 0; i < 8; ++i) ss += v[i] * v[i];
        ss += __shfl_xor(ss, 1); ss += __shfl_xor(ss, 2); ss += __shfl_xor(ss, 4); ss += __shfl_xor(ss, 8);
        float r = 1.0f / sqrtf(ss * (1.f / DH) + EPS);
        const bool isq = col < 1024;
        if (isq) r *= 0.08838834764831845f * LOG2E;
        const float* gp = (isq ? F.q_g : F.k_g) + l16 * 8;
        const f32x4 g0 = *(const f32x4*)gp, g1 = *(const f32x4*)(gp + 4);
        v4u o; o.x = pk2(v[0] * r * g0.x, v[1] * r * g0.y); o.y = pk2(v[2] * r * g0.z, v[3] * r * g0.w);
        o.z = pk2(v[4] * r * g1.x, v[5] * r * g1.y); o.w = pk2(v[6] * r * g1.z, v[7] * r * g1.w);
        *(GAS v4u*)p = o;
    }
}

constexpr int HP_QT = 0, HP_KT = 17408, HP_KDT = 60928, HP_VT = 79360, HP_AM = 97792, HP_QTOT = 107008, HP_RREF = 109056;
constexpr int QS = 136, TS = 72;
__device__ __forceinline__ void hg_prep_item(Frame& F, int item) {
    const int b = item >> 8, n = (item >> 3) & 31, h = item & 7;
    const int tid = F.tid, lane = F.lane, d = tid & 127, qtr = __builtin_amdgcn_readfirstlane(tid >> 7);
    const size_t m0 = (size_t)b * SEQ + (size_t)n * CHUNK;
    LAS bf16* QT = (LAS bf16*)(F.lds + HP_QT); LAS bf16* KT = (LAS bf16*)(F.lds + HP_KT); LAS bf16* KDT = (LAS bf16*)(F.lds + HP_KDT);
    LAS bf16* VT = (LAS bf16*)(F.lds + HP_VT); LAS bf16* AM = (LAS bf16*)(F.lds + HP_AM);
    LAS float* QTOT = (LAS float*)(F.lds + HP_QTOT); LAS float* RREF = (LAS float*)(F.lds + HP_RREF);
    const float l0 = F.lower_bounds[h * 128 + d], l1 = F.lower_bounds[1024 + h * 128 + d];
    const float lb = 1.0f / (1.0f + fexp(l1 - l0)), oml = 1.0f - lb;
    bf16* prow = F.PROJ + (m0 + 16 * qtr) * LDP + h * 128 + d;
    float q[16], kk[16], bb[16]; unsigned short vv[16];
    float run = 0.f;
#pragma unroll
    for (int i = 0; i < 16; ++i) {
        const float fr = bf2f(prow[(size_t)i * LDP + C_GF]); q[i] = bf2f(prow[(size_t)i * LDP + C_GQ]); vv[i] = prow[(size_t)i * LDP + C_GI];
        const float sg = __builtin_amdgcn_rcpf(1.0f + __builtin_amdgcn_exp2f(-LOG2E * fr));
        const float f = lb + oml * sg;
        run += __builtin_amdgcn_logf(f) * 0.6931471805599453f;
        bb[i] = run; kk[i] = oml * (1.0f - sg);
    }
    QTOT[qtr * 128 + d] = run;
    __syncthreads();
    float prefix = 0.f, total = 0.f;
#pragma unroll
    for (int j = 0; j < 4; ++j) { const float t = QTOT[j * 128 + d]; if (j < qtr) prefix += t; total += t; }
#pragma unroll
    for (int i = 0; i < 16; ++i) bb[i] += prefix;
    const float rown = bb[7];
    RREF[qtr * 128 + d] = rown;
    __syncthreads();
    float rr[4];
#pragma unroll
    for (int j = 0; j < 4; ++j) rr[j] = RREF[j * 128 + d];
#pragma unroll
    for (int i = 0; i < 16; ++i) QT[(16 * qtr + i) * QS + d] = (bf16)f2bf(q[i] * fexp(bb[i] - rown));
#pragma unroll
    for (int I = 0; I < 4; ++I) {
        if (I >= qtr) { const int pair = I * (I + 1) / 2 + qtr;
#pragma unroll
            for (int i = 0; i < 16; ++i) KT[pair * (16 * QS) + i * QS + d] = (bf16)f2bf(kk[i] * fexp(rr[I] - bb[i])); }
    }
    { unsigned kw[8], vw[8];
#pragma unroll
      for (int i = 0; i < 8; ++i) { kw[i] = pk2(kk[2 * i] * fexp(total - bb[2 * i]), kk[2 * i + 1] * fexp(total - bb[2 * i + 1])); vw[i] = (unsigned)vv[2 * i] | ((unsigned)vv[2 * i + 1] << 16); }
      LAS v4u* kp = (LAS v4u*)(KDT + d * TS + 16 * qtr); kp[0] = (v4u){kw[0], kw[1], kw[2], kw[3]}; kp[1] = (v4u){kw[4], kw[5], kw[6], kw[7]};
      LAS v4u* vp = (LAS v4u*)(VT + d * TS + 16 * qtr);  vp[0] = (v4u){vw[0], vw[1], vw[2], vw[3]}; vp[1] = (v4u){vw[4], vw[5], vw[6], vw[7]}; }
#pragma unroll
    for (int i = 0; i < 16; ++i) prow[(size_t)i * LDP + C_GQ] = (bf16)f2bf(q[i] * fexp(bb[i]));
    if (qtr == 0) F.DL[(size_t)item * 128 + d] = fexp(total);
    __syncthreads();
    const int c = lane & 15, g = lane >> 4, w = F.wave;
#pragma unroll
    for (int rep = 0; rep < 2; ++rep) {
        const int idx = w + 8 * rep;
        if (idx < 10) {
            const int I = (idx >= 6) ? 3 : (idx >= 3) ? 2 : (idx >= 1) ? 1 : 0, J = idx - I * (I + 1) / 2;
            f32x4 acc = {0.f, 0.f, 0.f, 0.f};
#pragma unroll
            for (int ks = 0; ks < 4; ++ks) {
                const bf16x8 a = *(const LAS bf16x8*)(KT + idx * (16 * QS) + c * QS + 32 * ks + 8 * g);
                const bf16x8 bq = *(const LAS bf16x8*)(QT + (16 * I + c) * QS + 32 * ks + 8 * g);
                acc = __builtin_amdgcn_mfma_f32_16x16x32_bf16(a, bq, acc, 0, 0, 0);
            }
            if (I == J) {
#pragma unroll
                for (int r = 0; r < 4; ++r) if (4 * g + r > c) acc[r] = 0.f; }
            *(LAS v2u*)(AM + (16 * I + c) * TS + 16 * J + 4 * g) = (v2u){pk2(acc[0], acc[1]), pk2(acc[2], acc[3])};
        } else if (idx < 12) {
            const int I = (idx == 10) ? 0 : 2, J = I + 1;
            *(LAS v2u*)(AM + (16 * I + c) * TS + 16 * J + 4 * g) = (v2u){0u, 0u};
        }
    }
    __syncthreads();
    bf16x8 vf[2];
#pragma unroll
    for (int ks = 0; ks < 2; ++ks) vf[ks] = *(const LAS bf16x8*)(VT + (16 * w + c) * TS + 32 * ks + 8 * g);
#pragma unroll
    for (int tt = 0; tt < 4; ++tt) {
        f32x4 acc = {0.f, 0.f, 0.f, 0.f};
#pragma unroll
        for (int ks = 0; ks < 2; ++ks) { if (ks == 1 && tt < 2) continue;
            const bf16x8 am = *(const LAS bf16x8*)(AM + (16 * tt + c) * TS + 32 * ks + 8 * g);
            acc = __builtin_amdgcn_mfma_f32_16x16x32_bf16(vf[ks], am, acc, 0, 0, 0); }
        *(GAS v2u*)(F.PROJ + (m0 + 16 * tt + c) * LDP + C_GF + h * 128 + 16 * w + 4 * g) = (v2u){pk2(acc[0], acc[1]), pk2(acc[2], acc[3])};
    }
#pragma unroll
    for (int dt = 0; dt < 8; ++dt) {
        f32x4 acc = {0.f, 0.f, 0.f, 0.f};
#pragma unroll
        for (int ks = 0; ks < 2; ++ks) {
            const bf16x8 kd = *(const LAS bf16x8*)(KDT + (16 * dt + c) * TS + 32 * ks + 8 * g);
            acc = __builtin_amdgcn_mfma_f32_16x16x32_bf16(kd, vf[ks], acc, 0, 0, 0); }
        *(GAS v2u*)(F.UT + ((size_t)item * 128 + 16 * w + c) * 128 + 16 * dt + 4 * g) = (v2u){pk2(acc[0], acc[1]), pk2(acc[2], acc[3])};
    }
    __syncthreads();
}

__device__ __forceinline__ void hg_sscan(Frame& F) {
    for (int vb = F.vcu; vb < BATCH * NH * 8; vb += F.G) {
        const int bh = vb >> 3, sub = vb & 7, b = bh >> 3, h = bh & 7;
        const int e = 16 * sub + (F.tid >> 5), dq = F.tid & 31;
        const size_t offe = (size_t)e * 128 + 4 * dq;
        f32x4 S = {0.f, 0.f, 0.f, 0.f};
#pragma unroll 1
        for (int n0 = 0; n0 < NCH; n0 += 16) {
            v2u uu[16]; f32x4 dl[16];
#pragma unroll
            for (int j = 0; j < 16; ++j) { const size_t item = (size_t)((b << 8) | ((n0 + j) << 3) | h);
                uu[j] = *(const GAS v2u*)(F.UT + item * 16384 + offe); dl[j] = *(const GAS f32x4*)(F.DL + item * 128 + 4 * dq); }
#pragma unroll
            for (int j = 0; j < 16; ++j) { const size_t item = (size_t)((b << 8) | ((n0 + j) << 3) | h);
                *(GAS v2u*)(F.SALL + item * 16384 + offe) = (v2u){pk2(S[0], S[1]), pk2(S[2], S[3])};
                const f32x4 uf = {bflo(uu[j].x), bfhi(uu[j].x), bflo(uu[j].y), bfhi(uu[j].y)};
                S = dl[j] * S + uf; }
        }
    }
}
__device__ __forceinline__ void hg_out_item(Frame& F, int item, int par) {
    const int b = item >> 8, n = (item >> 3) & 31, h = item & 7, w = F.wave, lane = F.lane, c = lane & 15, g = lane >> 4, e0 = 16 * w;
    LAS float* SSQ = (LAS float*)(F.lds) + (par & 1) * 512;
    const size_t m0 = (size_t)b * SEQ + (size_t)n * CHUNK;
    const f32x4 og = *(const f32x4*)(F.hg_g + e0 + 4 * g);
    bf16x8 sf[4];
#pragma unroll
    for (int ks = 0; ks < 4; ++ks) sf[ks] = *(const GAS bf16x8*)(F.SALL + ((size_t)item * 128 + e0 + c) * 128 + 32 * ks + 8 * g);
    f32x4 o[4]; v2u gw[4];
#pragma unroll
    for (int mt = 0; mt < 4; ++mt) {
        const bf16* rowp = F.PROJ + (m0 + 16 * mt + c) * LDP + h * 128;
        f32x4 acc = {0.f, 0.f, 0.f, 0.f};
#pragma unroll
        for (int ks = 0; ks < 4; ++ks) { const bf16x8 qf = *(const GAS bf16x8*)(rowp + C_GQ + 32 * ks + 8 * g); acc = __builtin_amdgcn_mfma_f32_16x16x32_bf16(sf[ks], qf, acc, 0, 0, 0); }
        const v2u iw = *(const GAS v2u*)(rowp + C_GF + e0 + 4 * g);
        gw[mt] = *(const GAS v2u*)(rowp + C_GZ + e0 + 4 * g);
        acc[0] += bflo(iw.x); acc[1] += bfhi(iw.x); acc[2] += bflo(iw.y); acc[3] += bfhi(iw.y);
        o[mt] = acc;
        float ss = (acc[0] * acc[0] + acc[1] * acc[1]) + (acc[2] * acc[2] + acc[3] * acc[3]);
        ss += __shfl_xor(ss, 16); ss += __shfl_xor(ss, 32);
        if (g == 0) SSQ[w * 64 + 16 * mt + c] = ss;
    }
    __syncthreads();
#pragma unroll
    for (int mt = 0; mt < 4; ++mt) {
        float tot = 0.f;
#pragma unroll
        for (int ww = 0; ww < 8; ++ww) tot += SSQ[ww * 64 + 16 * mt + c];
        const float rinv = 1.0f / sqrtf(tot * (1.f / 128.f) + EPS);
        const f32x4 v = o[mt] * rinv * og;
        *(GAS v2u*)(F.MIX + (m0 + 16 * mt + c) * DM + 1024 + h * 128 + e0 + 4 * g) = (v2u){pk2(v[0] * bflo(gw[mt].x), v[1] * bfhi(gw[mt].x)), pk2(v[2] * bflo(gw[mt].y), v[3] * bfhi(gw[mt].y))};
    }
}

namespace att {
constexpr int SHM_V = 16384, SHM_K = 16384, A_WS = 2 * SHM_V + 2 * SHM_K, A_BIAS = A_WS + NWAVES * 64 * 4, A_END = A_BIAS + 1040;
constexpr float THR2 = 8.0f * LOG2E;
#define KSWZ(row, colB) ((row) * 256 + ((colB) ^ (((row) & 7) << 4)))
#define SBAR() __builtin_amdgcn_sched_barrier(0)
__device__ __forceinline__ int crow(int r, int hi) { return (r & 3) + 8 * (r >> 2) + 4 * hi; }
__device__ __forceinline__ unsigned cvtpk(float lo, float hi) { unsigned r; asm volatile("v_cvt_pk_bf16_f32 %0, %1, %2" : "=v"(r) : "v"(lo), "v"(hi)); return r; }
__device__ __forceinline__ void partialSM(f32x16& p0, f32x16& p1, float& m_reg, float& alpha) {
  float pmax = p0[0];
#pragma unroll
  for (int r = 1; r < 16; ++r) pmax = fmaxf(pmax, p0[r]);
#pragma unroll
  for (int r = 0; r < 16; ++r) pmax = fmaxf(pmax, p1[r]);
  { auto rr = __builtin_amdgcn_permlane32_swap(__float_as_uint(pmax), __float_as_uint(pmax), false, false);
    pmax = fmaxf(__uint_as_float(rr[0]), __uint_as_float(rr[1])); }
  float mn;
  if (__builtin_expect(__all(pmax - m_reg <= THR2), 1)) { mn = m_reg; alpha = 1.f; }
  else { mn = fmaxf(m_reg, pmax); alpha = __builtin_amdgcn_exp2f(m_reg - mn); m_reg = mn; }
#pragma unroll
  for (int r = 0; r < 16; ++r) p0[r] = __builtin_amdgcn_exp2f(p0[r] - mn);
#pragma unroll
  for (int r = 0; r < 16; ++r) p1[r] = __builtin_amdgcn_exp2f(p1[r] - mn);
}
__device__ __forceinline__ void finishSM(f32x16& p0, f32x16& p1, float alpha, float& l_reg, bf16x8& pa0, bf16x8& pa1, bf16x8& pa2, bf16x8& pa3) {
  float ps = 0;
#pragma unroll
  for (int r = 0; r < 16; ++r) ps += p0[r];
#pragma unroll
  for (int r = 0; r < 16; ++r) ps += p1[r];
  { auto rr = __builtin_amdgcn_permlane32_swap(__float_as_uint(ps), __float_as_uint(ps), false, false);
    ps = __uint_as_float(rr[0]) + __uint_as_float(rr[1]); }
  l_reg = l_reg * alpha + ps;
#define PK4(P, BASE, OUT) do { unsigned a0 = cvtpk(P[BASE + 0], P[BASE + 1]), a1 = cvtpk(P[BASE + 2], P[BASE + 3]);   \
    unsigned b0 = cvtpk(P[BASE + 4], P[BASE + 5]), b1 = cvtpk(P[BASE + 6], P[BASE + 7]);                              \
    auto r0 = __builtin_amdgcn_permlane32_swap(a0, b0, false, false); auto r1 = __builtin_amdgcn_permlane32_swap(a1, b1, false, false); \
    v4u w_ = {r0[0], r1[0], r0[1], r1[1]}; OUT = __builtin_bit_cast(bf16x8, w_); } while (0)
  PK4(p0, 0, pa0); PK4(p0, 8, pa1); PK4(p1, 0, pa2); PK4(p1, 8, pa3);
#undef PK4
}
__device__ __forceinline__ void qkt(f32x16& p0, f32x16& p1, const LAS char* Ks, const bf16x8* qr, int r32, int hi) {
  p0 = f32x16{}; p1 = f32x16{};
#pragma unroll
  for (int d0 = 0; d0 < 8; ++d0) { const int cb = (d0 * 16 + hi * 8) * 2;
    const bf16x8 b0 = *(const LAS bf16x8*)(Ks + KSWZ(r32, cb));
    const bf16x8 b1 = *(const LAS bf16x8*)(Ks + KSWZ(32 + r32, cb));
    p0 = __builtin_amdgcn_mfma_f32_32x32x16_bf16(b0, qr[d0], p0, 0, 0, 0);
    p1 = __builtin_amdgcn_mfma_f32_32x32x16_bf16(b1, qr[d0], p1, 0, 0, 0); }
}
__device__ __forceinline__ int v_st(int k, int c) { const int kk = (k & ~0xC) | ((k & 4) << 1) | ((k & 8) >> 1); return ((kk >> 3) * 4 + (c >> 5)) * 512 + ((kk & 7) * 32 + (c & 31)) * 2; }
__device__ __forceinline__ int v_rd_base(int lane) { return ((lane & 3) << 3) | (((lane >> 2) & 3) << 6) | (((lane >> 4) & 1) << 5) | (((lane >> 5) & 1) << 8); }
constexpr int v_rd_off(int d0, int ks, int half) { return d0 * 512 + ks * 4096 + half * 2048; }
template <int OFF> __device__ __forceinline__ s16x4 tr_read(int vb) {
  s16x4 r; asm volatile("ds_read_b64_tr_b16 %0, %1 offset:%2" : "=&v"(r) : "v"(vb), "i"(OFF) : "memory"); return r;
}
template <int D0> __device__ __forceinline__ void pv_one(f32x16& od, int vb, bf16x8 pa0, bf16x8 pa1, bf16x8 pa2, bf16x8 pa3) {
  const s16x4 l0 = tr_read<v_rd_off(D0, 0, 0)>(vb), h0 = tr_read<v_rd_off(D0, 0, 1)>(vb), l1 = tr_read<v_rd_off(D0, 1, 0)>(vb), h1 = tr_read<v_rd_off(D0, 1, 1)>(vb);
  const s16x4 l2 = tr_read<v_rd_off(D0, 2, 0)>(vb), h2 = tr_read<v_rd_off(D0, 2, 1)>(vb), l3 = tr_read<v_rd_off(D0, 3, 0)>(vb), h3 = tr_read<v_rd_off(D0, 3, 1)>(vb);
  asm volatile("s_waitcnt lgkmcnt(0)" ::: "memory"); SBAR();
#define PK(L, H) (bf16x8){L[0], L[1], L[2], L[3], H[0], H[1], H[2], H[3]}
  od = __builtin_amdgcn_mfma_f32_32x32x16_bf16(pa0, PK(l0, h0), od, 0, 0, 0);
  od = __builtin_amdgcn_mfma_f32_32x32x16_bf16(pa1, PK(l1, h1), od, 0, 0, 0);
  od = __builtin_amdgcn_mfma_f32_32x32x16_bf16(pa2, PK(l2, h2), od, 0, 0, 0);
  od = __builtin_amdgcn_mfma_f32_32x32x16_bf16(pa3, PK(l3, h3), od, 0, 0, 0);
#undef PK
}
__device__ __forceinline__ void pv_d0(f32x16* o, int vb, bf16x8 pa0, bf16x8 pa1, bf16x8 pa2, bf16x8 pa3) {
  pv_one<0>(o[0], vb, pa0, pa1, pa2, pa3); pv_one<1>(o[1], vb, pa0, pa1, pa2, pa3); pv_one<2>(o[2], vb, pa0, pa1, pa2, pa3); pv_one<3>(o[3], vb, pa0, pa1, pa2, pa3);
}

__device__ __forceinline__ void attn_unit(int b, int h, int u, const bf16* PROJ, bf16* MIX, const float* rel_bias, LAS unsigned char* lds) {
  const int tid = threadIdx.x, lane = tid & 63, r32 = lane & 31, hi = lane >> 5; const int wid = __builtin_amdgcn_readfirstlane(tid >> 6);
  LAS char* V_lds = (LAS char*)lds; LAS char* K_lds = (LAS char*)lds + 2 * SHM_V;
  LAS float* ws = (LAS float*)(lds + A_WS) + wid * 64; LAS float* li_l = ws; LAS float* al_l = ws + 32;
  LAS float* bl = (LAS float*)(lds + A_BIAS);
  if (tid < 257) { const float far = rel_bias[h * 257 + 256]; bl[tid] = (rel_bias[h * 257 + tid] - far) * LOG2E; }
  float m_reg = -1e30f, l_reg = 0; f32x16 o[4] = {}; bf16x8 qr[8];
  const size_t mrow0 = (size_t)b * SEQ + 256 * u;
  const bf16* Qw = PROJ + (mrow0 + wid * 32 + r32) * LDP + C_AQ + h * 128 + hi * 8;
#pragma unroll
  for (int d0 = 0; d0 < 8; ++d0) qr[d0] = *(const GAS bf16x8*)(Qw + d0 * 16);
  const bf16* Kh = PROJ + (size_t)b * SEQ * LDP + C_AK + h * 128; const bf16* Vh = PROJ + (size_t)b * SEQ * LDP + C_AV + h * 128;
  const int sr = tid >> 4, sc = (tid & 15) * 8, vst0 = v_st(sr, sc), vst1 = v_st(32 + sr, sc);
  const int vb0 = (int)(uintptr_t)V_lds + v_rd_base(lane);
  const int cw = 4 * u + (wid >> 1), kc_lo = (4 * u - 8 > 0) ? 4 * u - 8 : 0, NT = 4 * u + 3 - kc_lo + 1;
  const int qloc = 32 * (wid & 1) + r32;
  bf16x8 vs0, vs1, ks0, ks1;
#define SLOAD(k0) do { vs0 = *(const GAS bf16x8*)(Vh + (size_t)((k0) + sr) * LDP + sc); vs1 = *(const GAS bf16x8*)(Vh + (size_t)((k0) + 32 + sr) * LDP + sc); \
    ks0 = *(const GAS bf16x8*)(Kh + (size_t)((k0) + sr) * LDP + sc); ks1 = *(const GAS bf16x8*)(Kh + (size_t)((k0) + 32 + sr) * LDP + sc); } while (0)
#define SWRITE(bb) do { *(LAS bf16x8*)(V_lds + (bb) * SHM_V + vst0) = vs0; *(LAS bf16x8*)(V_lds + (bb) * SHM_V + vst1) = vs1; const int kc_ = sc * 2; \
    *(LAS bf16x8*)(K_lds + (bb) * SHM_K + KSWZ(sr, kc_)) = ks0; *(LAS bf16x8*)(K_lds + (bb) * SHM_K + KSWZ(32 + sr, kc_)) = ks1; } while (0)
  SLOAD(kc_lo * 64); SWRITE(0); __syncthreads();
  for (int j = 0; j < NT; ++j) {
    const int kc = kc_lo + j, buf = j & 1;
    if (j + 1 < NT) SLOAD((kc + 1) * 64);
    if (kc >= cw - 8 && kc <= cw) {
      f32x16 p0, p1; float alpha; bf16x8 pa0, pa1, pa2, pa3;
      qkt(p0, p1, K_lds + buf * SHM_K, qr, r32, hi);
      const int delta = cw - kc;
      if (delta <= 2) {
        const int base = delta * 64 + qloc + 128;
#pragma unroll
        for (int r = 0; r < 16; ++r) { const int i0 = base - crow(r, hi), i1 = i0 - 32;
          p0[r] += bl[i0 > 256 ? 256 : i0]; p1[r] += bl[i1 > 256 ? 256 : i1]; }
      }
      partialSM(p0, p1, m_reg, alpha);
      if (__any(alpha < 1.f)) { if (hi == 0) al_l[r32] = alpha; asm volatile("s_waitcnt lgkmcnt(0)" ::: "memory");
#pragma unroll
        for (int d = 0; d < 4; ++d)
#pragma unroll
          for (int r = 0; r < 16; ++r) o[d][r] *= al_l[crow(r, hi)]; }
      finishSM(p0, p1, alpha, l_reg, pa0, pa1, pa2, pa3); SBAR();
      pv_d0(o, vb0 + buf * SHM_V, pa0, pa1, pa2, pa3);
    }
    if (j + 1 < NT) SWRITE(buf ^ 1);
    __syncthreads();
  }
#undef SLOAD
#undef SWRITE
  if (hi == 0) li_l[r32] = l_reg; asm volatile("s_waitcnt lgkmcnt(0)" ::: "memory");
  float rli[16];
#pragma unroll
  for (int r = 0; r < 16; ++r) rli[r] = __builtin_amdgcn_rcpf(li_l[crow(r, hi)]);
#pragma unroll
  for (int r = 0; r < 16; ++r) { const size_t row = mrow0 + wid * 32 + crow(r, hi);
#pragma unroll
    for (int d0 = 0; d0 < 4; ++d0) { const float gz = bf2f(PROJ[row * LDP + C_AZ + h * 128 + d0 * 32 + r32]);
      MIX[row * DM + h * 128 + d0 * 32 + r32] = (bf16)f2bf(o[d0][r] * rli[r] * gz); } }
  __syncthreads();
}
#undef KSWZ
#undef SBAR
}

struct Args { const float* in[12]; float* out; unsigned char* ws; int ph_lo, ph_hi, li, pad; };
__global__ void __launch_bounds__(NWAVES * 64, 2) hymba_fwd(Args args) {
    extern __shared__ __attribute__((aligned(16))) unsigned char lds[];
    Frame F;
    F.lds = (LAS unsigned char*)lds;
    F.MISC = (volatile LAS unsigned*)(F.lds + MISC_OFF);
    F.tid = threadIdx.x; F.lane = F.tid & 63; F.wave = __builtin_amdgcn_readfirstlane(F.tid >> 6);
    F.G = gridDim.x; { const int bx = blockIdx.x; F.vcu = (F.G % 8 == 0) ? (bx % 8) * (F.G / 8) + bx / 8 : bx; }
    unsigned char* ws = args.ws;
    F.ctl = (gu32*)(ws + WS_CTL);
    F.x = args.in[0]; F.c = args.in[1]; F.norm_g = args.in[2]; F.w_ada = args.in[3]; F.b_ada = args.in[4]; F.w_in = args.in[5];
    F.q_g = args.in[6]; F.k_g = args.in[7]; F.rel_bias = args.in[8]; F.lower_bounds = args.in[9]; F.hg_g = args.in[10]; F.w_out = args.in[11];
    F.out = args.out; F.mod = (float*)(ws + WS_CTL) + CW_MOD;
    F.WIN = (bf16*)(ws + WS_WIN); F.WOUT = (bf16*)(ws + WS_WOUT); F.HB = (bf16*)(ws + WS_H); F.MIX = (bf16*)(ws + WS_MIX);
    F.PROJ = (bf16*)(ws + WS_PROJ); F.UT = (bf16*)(ws + WS_UT); F.DL = (float*)(ws + WS_DL); F.SALL = (bf16*)(ws + WS_SALL);
    for (int u = F.tid; u < (LDS_BYTES - LDSCTL_OFF) / 4; u += NWAVES * 64) ((LAS unsigned*)(F.lds + LDSCTL_OFF))[u] = 0u;
    __syncthreads();
    XcdBarrier bar; bar.bar = (unsigned*)(F.ctl + CW_BAR); bar.x = 0; bar.st = nullptr;
    if (N_LAUNCHES == 1) bar = xcd_barrier_post((unsigned*)(F.ctl + CW_BAR), F.MISC + 8);
#define GRID_BAR() do { if (N_LAUNCHES == 1) xcd_barrier(bar); } while (0)
    const int lo = args.ph_lo, hi = args.ph_hi;
#define IN(k) (lo <= (k) && (k) < hi)
#define BOTH(k) (IN(k) && IN((k) + 1))

    if (IN(0)) { p0_prologue(F); if (BOTH(0)) GRID_BAR(); }
    if (IN(1)) { for (int rep = 0; rep < REP1; ++rep) p1_rows(F); if (BOTH(1)) GRID_BAR(); }
    if (IN(2)) {
        pg8::Gemm g{F.HB, F.WIN, MROWS, NIN, DM}; pg8::StaticOrder S; S.init(MROWS, NIN, F.G, (int)blockIdx.x);
        pg8::EpiProj E{F.PROJ, LDP};
        for (int rep = 0; rep < REP2; ++rep) { pg8::gemm_phase<pg8::EpiProj, pg8::StaticOrder, true, true>(F.lds + RING_OFF, g, S, E); if (rep + 1 < REP2) GRID_BAR(); }
        if (BOTH(2)) GRID_BAR();
    }
    if (IN(3)) {
        for (int it = F.vcu; it < BATCH * NCH * NH; it += F.G) hg_prep_item(F, it);
        p3_qknorm(F);
        if (BOTH(3)) GRID_BAR();
    }
    if (IN(4)) { hg_sscan(F); if (BOTH(4)) GRID_BAR(); }
    if (IN(5)) {
        for (int i = F.vcu; i < BATCH * NH * 8; i += F.G) {
            const int bh = i >> 3, u = i & 7;
            const int cnt = (u == 0) ? 8 : (u == 1) ? 6 : 3, first = (u == 0) ? 0 : (u == 1) ? 8 : 14 + 3 * (u - 2);
            for (int k = 0; k < cnt; ++k) hg_out_item(F, ((bh >> 3) << 8) | ((first + k) << 3) | (bh & 7), k);
            __syncthreads();
            for (int rep = 0; rep < REP4A; ++rep) att::attn_unit(bh >> 3, bh & 7, u, F.PROJ, F.MIX, F.rel_bias, F.lds);
        }
        if (BOTH(5)) GRID_BAR();
    }
    if (IN(6)) {
        pg8::Gemm g{F.MIX, F.WOUT, MROWS, DM, DM}; pg8::StaticOrder S; S.init(MROWS, DM, F.G, (int)blockIdx.x);
        pg8::EpiOut E{F.x, F.out, F.mod + 2 * DM};
        for (int rep = 0; rep < REP5; ++rep) { pg8::gemm_phase<pg8::EpiOut, pg8::StaticOrder, true, true>(F.lds + RING_OFF, g, S, E); if (rep + 1 < REP5) GRID_BAR(); }
    }
#undef IN
#undef BOTH
#undef GRID_BAR
}

extern "C" void kernel_launch(void* const* d_in, const int* in_sizes, int n_in, void* d_out, int out_size, void* d_ws, size_t ws_size, hipStream_t stream) {
    static int grid = 0;
    if (grid == 0) {
        if (n_in != 12 || in_sizes[0] != MROWS * DM || out_size != MROWS * DM || ws_size < WS_END) {
            fprintf(stderr, "kernel_launch: shape mismatch: n_in %d in0 %d out %d ws %zu (need %zu)\n", n_in, n_in > 0 ? in_sizes[0] : -1, out_size, ws_size, (size_t)WS_END); grid = -1; return; }
        int dev = 0, cus = 0, per_cu = 0;
        if (hipGetDevice(&dev) != hipSuccess || hipDeviceGetAttribute(&cus, hipDeviceAttributeMultiprocessorCount, dev) != hipSuccess) { fprintf(stderr, "kernel_launch: device query failed\n"); grid = -1; return; }
        if (hipFuncSetAttribute((const void*)hymba_fwd, hipFuncAttributeMaxDynamicSharedMemorySize, LDS_BYTES) != hipSuccess) { fprintf(stderr, "kernel_launch: hipFuncSetAttribute failed\n"); grid = -1; return; }
        if (hipOccupancyMaxActiveBlocksPerMultiprocessor(&per_cu, (const void*)hymba_fwd, NWAVES * 64, LDS_BYTES) != hipSuccess || per_cu < 1) {
            fprintf(stderr, "kernel_launch: occupancy query reports %d workgroups per CU; not launching\n", per_cu); (void)hipGetLastError(); grid = -1; return; }
        grid = cus;
        if (grid % 8 != 0 || grid > 256) grid = (grid > 256) ? 256 : (grid / 8) * 8;
    }
    if (grid <= 0) return;
    if (hipMemsetAsync((char*)d_ws + WS_CTL, 0, CTL_ZERO_BYTES, stream) != hipSuccess) { fprintf(stderr, "kernel_launch: memset failed\n"); return; }
    Args a{};
    for (int i = 0; i < 12; ++i) a.in[i] = (const float*)d_in[i];
    a.out = (float*)d_out; a.ws = (unsigned char*)d_ws;
    if (N_LAUNCHES == 1) {
        a.ph_lo = 0; a.ph_hi = PER_PHASE; a.li = 0;
        void* kargs[] = {&a};
        hipError_t e = hipLaunchCooperativeKernel((const void*)hymba_fwd, dim3(grid), dim3(NWAVES * 64), kargs, LDS_BYTES, stream);
        if (e != hipSuccess) fprintf(stderr, "kernel_launch: cooperative launch failed: %s (grid %d)\n", hipGetErrorString(e), grid);
    } else {
        for (int li = 0; li < PER_PHASE; ++li) {
            a.ph_lo = li; a.ph_hi = li + 1; a.li = li;
            hipLaunchKernelGGL(hymba_fwd, dim3(grid), dim3(NWAVES * 64), LDS_BYTES, stream, a);
            const hipError_t le = hipPeekAtLastError();
            if (le != hipSuccess) { fprintf(stderr, "kernel_launch: launch %d failed: %s\n", li, hipGetErrorName(le)); break; }
        }
    }
}
```

```cpp
#include <hip/hip_runtime.h>
#include <cstdio>
#include <cstdint>

#ifndef MK_N_LAUNCHES
#define MK_N_LAUNCHES 1
#endif
#ifndef REP0T
#define REP0T 1
#endif
#ifndef REP1
#define REP1 1
#endif
#ifndef REP2
#define REP2 1
#endif
#ifndef REP4S
#define REP4S 1
#endif
#ifndef REP4A
#define REP4A 1
#endif
#ifndef REP5
#define REP5 1
#endif
#ifndef REP3P
#define REP3P 0
#endif
#ifndef REP0A
#define REP0A 0
#endif
#ifndef REPBAR
#define REPBAR 0
#endif
#ifndef REP3N
#define REP3N 0
#endif
#ifndef REP4SS
#define REP4SS 1
#endif
#ifndef REP4O
#define REP4O 1
#endif
namespace pg8 {
#define PG8_LAS __attribute__((address_space(3)))
typedef unsigned short bf16_t;
typedef short bf16x8 __attribute__((ext_vector_type(8)));
typedef float f32x4 __attribute__((ext_vector_type(4)));
typedef unsigned u32x4 __attribute__((ext_vector_type(4)));
constexpr int BM = 256, BK = 64, HALF = 128, HTB = HALF * BK * 2  , STAGE_BYTES = 8 * HTB, NXCD = 8, WGM = 8;

__host__ __device__ __forceinline__ int lds_byte(int r, int c) { const int st = (r >> 4) * 2 + (c >> 5), rr = r & 15, cc = c & 31, ob = rr * 64 + cc * 2; return st * 1024 + (ob ^ (((ob >> 9) & 1) << 5)); }
__host__ __device__ __forceinline__ void stage_rc(int b, int& R, int& C) { const int st = b / 1024, sb = b % 1024, swz = sb ^ (((sb >> 9) & 1) << 5); R = (st >> 1) * 16 + swz / 64; C = (st & 1) * 32 + (swz % 64) / 2; }
__host__ __device__ __forceinline__ int perm32(int rho) { const int n = rho >> 4, i = rho & 15; return 8 * (i >> 2) + 4 * n + (i & 3); }

struct Unit { int pm, pn; };
struct Gemm { const bf16_t* A; const bf16_t* Bt; int M, N, K; };

struct StaticOrder {
    int nM, nN, nwg, G, c;
    __host__ __device__ void init(int M, int N, int G_, int c_) { nM = M / BM; nN = N / BM; nwg = nM * nN; G = G_; c = c_; }
    __host__ __device__ bool next(int i, Unit& u) const {
        const long L = (long)i * G + c; if (L >= nwg) return false;
        int wgid = (int)L; { const int q = nwg / NXCD, r = nwg % NXCD, xcd = wgid % NXCD, off = wgid / NXCD; wgid = (xcd < r ? xcd * (q + 1) : r * (q + 1) + (xcd - r) * q) + off; }
        const int nig = WGM * nN, gid = wgid / nig, fm = gid * WGM, gsz = (nM - fm) < WGM ? (nM - fm) : WGM;
        u.pm = fm + ((wgid % nig) % gsz); u.pn = (wgid % nig) / gsz; return true;
    }
    __device__ __forceinline__ void a_ready(const Unit&) const {}
    __device__ __forceinline__ void done(const Unit&) const {}
};

__device__ __forceinline__ unsigned cvt_pk_bf16(float lo, float hi) { unsigned r; asm volatile("v_cvt_pk_bf16_f32 %0, %1, %2" : "=v"(r) : "v"(lo), "v"(hi)); return r; }
__device__ __forceinline__ float silu_f(float v) { return v * __builtin_amdgcn_rcpf(1.0f + __builtin_amdgcn_exp2f(-1.4426950408889634f * v)); }
struct EpiProj {
    static constexpr bool PERM = true, AFTER_DRAIN = false;
    bf16_t* O; int ldc;
    __device__ __forceinline__ void operator()(const f32x4 (&acc)[2][2][4][2], const Unit& u, int wr, int wc, int fr, int fq) const {
        const int row0 = u.pm * BM + wr * 64 + fr, col0 = u.pn * BM + wc * 32 + 8 * fq;
        const int grp = u.pn >> 2; const bool act = (grp == 3) || (grp == 4) || (grp == 7);
#pragma unroll
        for (int ai = 0; ai < 2; ++ai)
#pragma unroll
            for (int m = 0; m < 4; ++m) { bf16_t* rowp = O + (size_t)(row0 + ai * HALF + m * 16) * ldc + col0;
#pragma unroll
                for (int bj = 0; bj < 2; ++bj) { f32x4 v0 = acc[ai][bj][m][0], v1 = acc[ai][bj][m][1];
                    if (act) {
#pragma unroll
                        for (int i = 0; i < 4; ++i) { v0[i] = silu_f(v0[i]); v1[i] = silu_f(v1[i]); } }
                    u32x4 w; w.x = cvt_pk_bf16(v0[0], v0[1]); w.y = cvt_pk_bf16(v0[2], v0[3]); w.z = cvt_pk_bf16(v1[0], v1[1]); w.w = cvt_pk_bf16(v1[2], v1[3]);
                    *(u32x4*)(rowp + bj * HALF) = w; } }
    }
};
struct EpiOut {
    static constexpr bool PERM = false, AFTER_DRAIN = false;
    const float* x; float* out; const float* gate;
    __device__ __forceinline__ void operator()(const f32x4 (&acc)[2][2][4][2], const Unit& u, int wr, int wc, int fr, int fq) const {
        const int row0 = u.pm * BM + wr * 64 + fr, col0 = u.pn * BM + wc * 32 + 4 * fq;
        const float* gp = gate + (size_t)(u.pm >> 3) * 6144 + col0;
        f32x4 gv[2][2];
#pragma unroll
        for (int bj = 0; bj < 2; ++bj)
#pragma unroll
            for (int n = 0; n < 2; ++n) gv[bj][n] = *(const f32x4*)(gp + bj * HALF + n * 16);
#pragma unroll
        for (int ai = 0; ai < 2; ++ai)
#pragma unroll
            for (int m = 0; m < 4; ++m) { const size_t off = (size_t)(row0 + ai * HALF + m * 16) * 2048 + col0;
#pragma unroll
                for (int bj = 0; bj < 2; ++bj)
#pragma unroll
                    for (int n = 0; n < 2; ++n) { const f32x4 xv = *(const f32x4*)(x + off + bj * HALF + n * 16);
                        *(f32x4*)(out + off + bj * HALF + n * 16) = xv + gv[bj][n] * acc[ai][bj][m][n]; } }
    }
};

template <class Epi, class Sched, bool ALIGN_EPI = false, bool SP2 = false>
__device__ __forceinline__ void gemm_phase(PG8_LAS unsigned char* lds, const Gemm g, const Sched& S, const Epi& E) {
    const int tid = threadIdx.x, wid = __builtin_amdgcn_readfirstlane(tid >> 6), lane = tid & 63, wr = wid >> 2, wc = wid & 3, fr = lane & 15, fq = lane >> 4;
    const int K = g.K, nt = K / BK;
    unsigned voffA[2], voffB[2];
#pragma unroll
    for (int i = 0; i < 2; ++i) { int R, C; stage_rc(tid * 16 + i * 8192, R, C); const int Rb = Epi::PERM ? ((R & ~31) + perm32(R & 31)) : R;
        voffA[i] = (unsigned)(R * K + C) * 2u; voffB[i] = (unsigned)(Rb * K + C) * 2u; }
    const size_t kstep = (size_t)(BK * 2);
    const size_t hstep = (size_t)HALF * K * 2;
    const size_t tstep = 2 * hstep;
    const unsigned ldsw = (unsigned)wid * 1024u;
    const int aoff = lds_byte(wr * 64 + fr, fq * 8), boff = lds_byte(wc * 32 + fr, fq * 8);
#define PG8_SA(b, h) (((b) * 2 + (h)) * HTB)
#define PG8_SB(b, h) ((4 + (b) * 2 + (h)) * HTB)
#define PG8_STAGE(bufoff, gbase, voff) do { _Pragma("unroll") for (int _i = 0; _i < 2; ++_i) \
        __builtin_amdgcn_global_load_lds((const unsigned*)((const char*)(gbase) + (voff)[_i]), (PG8_LAS unsigned*)(lds + (bufoff) + ldsw + _i * 8192), 16, 0, 0); } while (0)
#define PG8_LDA(dst, b, h) do { _Pragma("unroll") for (int m = 0; m < 4; ++m) _Pragma("unroll") for (int k = 0; k < 2; ++k) dst[m][k] = *(const PG8_LAS bf16x8*)(lds + PG8_SA(b, h) + aoff + m * 2048 + k * 1024); } while (0)
#define PG8_LDB(dst, b, h) do { _Pragma("unroll") for (int n = 0; n < 2; ++n) _Pragma("unroll") for (int k = 0; k < 2; ++k) dst[n][k] = *(const PG8_LAS bf16x8*)(lds + PG8_SB(b, h) + boff + n * 2048 + k * 1024); } while (0)
#define PG8_MMA(ai, bj, At, Bt) do { __builtin_amdgcn_s_setprio(1); _Pragma("unroll") for (int m = 0; m < 4; ++m) _Pragma("unroll") for (int n = 0; n < 2; ++n) _Pragma("unroll") for (int k = 0; k < 2; ++k) \
        acc[ai][bj][m][n] = __builtin_amdgcn_mfma_f32_16x16x32_bf16(Bt[n][k], At[m][k], acc[ai][bj][m][n], 0, 0, 0); __builtin_amdgcn_s_setprio(0); } while (0)
#define PG8_WAIT_V(n) asm volatile("s_waitcnt vmcnt(" #n ")" ::: "memory")
#define PG8_WAIT_L(n) asm volatile("s_waitcnt lgkmcnt(" #n ")" ::: "memory")
#define PG8_BAR __builtin_amdgcn_s_barrier()
#define PG8_SCHED __builtin_amdgcn_sched_barrier(0)
    Unit cur, nxt; int ui = 0;
    if (!S.next(0, cur)) return;
    f32x4 acc[2][2][4][2];
#pragma unroll
    for (int a = 0; a < 2; ++a)
#pragma unroll
        for (int b = 0; b < 2; ++b)
#pragma unroll
            for (int m = 0; m < 4; ++m)
#pragma unroll
                for (int n = 0; n < 2; ++n) acc[a][b][m][n] = (f32x4){0.f, 0.f, 0.f, 0.f};
    bf16x8 At[4][2], B0[2][2], B1[2][2];
    const char* cA = (const char*)g.A + (size_t)cur.pm * tstep; const char* cB = (const char*)g.Bt + (size_t)cur.pn * tstep;
    S.a_ready(cur);
    if constexpr (SP2) {
        PG8_STAGE(PG8_SB(0, 0), cB, voffB); PG8_STAGE(PG8_SB(0, 1), cB + hstep, voffB); PG8_STAGE(PG8_SA(0, 0), cA, voffA); PG8_STAGE(PG8_SA(0, 1), cA + hstep, voffA);
        if (wr == 1) PG8_BAR;
        PG8_WAIT_V(2); PG8_BAR;
        PG8_STAGE(PG8_SB(1, 0), cB + kstep, voffB); PG8_STAGE(PG8_SA(1, 0), cA + kstep, voffA); PG8_STAGE(PG8_SB(1, 1), cB + hstep + kstep, voffB);
        PG8_WAIT_V(6); PG8_BAR;
    } else {
        PG8_STAGE(PG8_SB(0, 0), cB, voffB); PG8_STAGE(PG8_SA(0, 0), cA, voffA); PG8_STAGE(PG8_SB(0, 1), cB + hstep, voffB); PG8_STAGE(PG8_SA(0, 1), cA + hstep, voffA);
        if (wr == 1) PG8_BAR;
        PG8_WAIT_V(4); PG8_BAR;
        PG8_STAGE(PG8_SB(1, 0), cB + kstep, voffB); PG8_STAGE(PG8_SA(1, 0), cA + kstep, voffA); PG8_STAGE(PG8_SB(1, 1), cB + hstep + kstep, voffB);
        PG8_WAIT_V(6); PG8_BAR;
    }
    for (;;) {
        const bool has_next = S.next(ui + 1, nxt);
        const char* nA = has_next ? (const char*)g.A + (size_t)nxt.pm * tstep : cA; const char* nB = has_next ? (const char*)g.Bt + (size_t)nxt.pn * tstep : cB;
        for (int t = 0; t < nt; t += 2) {
            const bool last = (t == nt - 2);
            const char* a1 = cA + (size_t)(t + 1) * kstep;
            const char* a2 = last ? nA : cA + (size_t)(t + 2) * kstep; const char* b2 = last ? nB : cB + (size_t)(t + 2) * kstep;
            const char* a3 = a2 + kstep; const char* b3 = b2 + kstep;
            if (last && has_next) S.a_ready(nxt);
            if constexpr (SP2) {
            PG8_LDB(B0, 0, 0); PG8_LDB(B1, 0, 1); PG8_SCHED; PG8_LDA(At, 0, 0); PG8_STAGE(PG8_SA(1, 1), a1 + hstep, voffA);
            PG8_WAIT_V(8); PG8_WAIT_L(0); PG8_BAR; PG8_MMA(0, 0, At, B0); PG8_MMA(0, 1, At, B1); PG8_BAR; PG8_SCHED;
            PG8_LDA(At, 0, 1); PG8_STAGE(PG8_SB(0, 0), b2, voffB); PG8_STAGE(PG8_SB(0, 1), b2 + hstep, voffB); PG8_STAGE(PG8_SA(0, 0), a2, voffA);
            PG8_WAIT_V(8); PG8_WAIT_L(0); PG8_BAR; PG8_MMA(1, 0, At, B0); PG8_MMA(1, 1, At, B1); PG8_BAR; PG8_SCHED;
            PG8_LDB(B0, 1, 0); PG8_LDB(B1, 1, 1); PG8_SCHED; PG8_LDA(At, 1, 0); PG8_STAGE(PG8_SA(0, 1), a2 + hstep, voffA);
            PG8_WAIT_V(8); PG8_WAIT_L(0); PG8_BAR; PG8_MMA(0, 0, At, B0); PG8_MMA(0, 1, At, B1); PG8_BAR; PG8_SCHED;
            PG8_LDA(At, 1, 1); PG8_STAGE(PG8_SB(1, 0), b3, voffB); PG8_STAGE(PG8_SB(1, 1), b3 + hstep, voffB); PG8_STAGE(PG8_SA(1, 0), a3, voffA);
            PG8_WAIT_V(8); PG8_WAIT_L(0); PG8_BAR; PG8_MMA(1, 0, At, B0); PG8_MMA(1, 1, At, B1); PG8_BAR; PG8_SCHED;
            } else {
            PG8_LDB(B0, 0, 0); PG8_SCHED; PG8_LDA(At, 0, 0); PG8_STAGE(PG8_SA(1, 1), a1 + hstep, voffA);
            PG8_WAIT_L(8); PG8_BAR; PG8_WAIT_L(0); PG8_MMA(0, 0, At, B0); PG8_BAR; PG8_SCHED;
            PG8_LDB(B1, 0, 1); PG8_STAGE(PG8_SB(0, 0), b2, voffB);
            PG8_BAR; PG8_WAIT_L(0); PG8_MMA(0, 1, At, B1); PG8_BAR;
            PG8_LDA(At, 0, 1); PG8_STAGE(PG8_SA(0, 0), a2, voffA);
            PG8_BAR; PG8_WAIT_L(0); PG8_MMA(1, 0, At, B0); PG8_BAR; PG8_SCHED;
            PG8_STAGE(PG8_SB(0, 1), b2 + hstep, voffB);
            PG8_WAIT_V(6); PG8_BAR; PG8_MMA(1, 1, At, B1); PG8_BAR;
            PG8_LDB(B0, 1, 0); PG8_SCHED; PG8_LDA(At, 1, 0); PG8_STAGE(PG8_SA(0, 1), a2 + hstep, voffA);
            PG8_WAIT_L(8); PG8_BAR; PG8_WAIT_L(0); PG8_MMA(0, 0, At, B0); PG8_BAR; PG8_SCHED;
            PG8_LDB(B1, 1, 1); PG8_STAGE(PG8_SB(1, 0), b3, voffB);
            PG8_BAR; PG8_WAIT_L(0); PG8_MMA(0, 1, At, B1); PG8_BAR;
            PG8_LDA(At, 1, 1); PG8_STAGE(PG8_SA(1, 0), a3, voffA);
            PG8_BAR; PG8_WAIT_L(0); PG8_MMA(1, 0, At, B0); PG8_BAR; PG8_SCHED;
            PG8_STAGE(PG8_SB(1, 1), b3 + hstep, voffB);
            PG8_WAIT_V(6); PG8_BAR; PG8_MMA(1, 1, At, B1); PG8_BAR;
            }
        }
        if constexpr (ALIGN_EPI) { if (wr == 0) PG8_BAR; }
        if constexpr (!Epi::AFTER_DRAIN) { E(acc, cur, wr, wc, fr, fq); S.done(cur); }
        if (!has_next) break;
#pragma unroll
        for (int a = 0; a < 2; ++a)
#pragma unroll
            for (int b = 0; b < 2; ++b)
#pragma unroll
                for (int m = 0; m < 4; ++m)
#pragma unroll
                    for (int n = 0; n < 2; ++n) acc[a][b][m][n] = (f32x4){0.f, 0.f, 0.f, 0.f};
        cur = nxt; cA = nA; cB = nB; ++ui;
        if constexpr (ALIGN_EPI) { if (wr == 1) PG8_BAR; }
    }
    PG8_WAIT_V(0);
    if constexpr (!ALIGN_EPI) { if (wr == 0) PG8_BAR; }
    PG8_BAR;
    if constexpr (Epi::AFTER_DRAIN) { E.fused(acc, cur, wr, wc, fr, fq, lds, wid, lane); S.done(cur); }
#undef PG8_SA
#undef PG8_SB
#undef PG8_STAGE
#undef PG8_LDA
#undef PG8_LDB
#undef PG8_MMA
#undef PG8_WAIT_V
#undef PG8_WAIT_L
#undef PG8_BAR
#undef PG8_SCHED
}
}

constexpr int NWAVES = 8;
constexpr int N_LAUNCHES = MK_N_LAUNCHES;
constexpr int PER_PHASE = 7;
constexpr int DM = 2048, BATCH = 4, SEQ = 2048, MROWS = BATCH * SEQ, NIN = 8192, CHUNK = 64, NCH = SEQ / CHUNK, NH = 8, DH = 128;
constexpr int LDP = NIN;
constexpr int C_AQ = 0, C_AK = 1024, C_AV = 2048, C_AZ = 3072, C_GQ = 4096, C_GF = 5120, C_GI = 6144, C_GZ = 7168;
constexpr float EPS = 1e-6f, LOG2E = 1.4426950408889634f;

constexpr size_t MiB = 1u << 20;
constexpr size_t WS_CTL = 0, CTL_ZERO_BYTES = 1 * MiB;
constexpr size_t WS_WIN = 2 * MiB;
constexpr size_t WS_UT = 2 * MiB;
constexpr size_t WS_WOUT = 34 * MiB;
constexpr size_t WS_H = 42 * MiB;
constexpr size_t WS_MIX = 42 * MiB;
constexpr size_t WS_PROJ = 74 * MiB;
constexpr size_t WS_DL = 202 * MiB;
constexpr size_t WS_SALL = 203 * MiB;
constexpr size_t WS_END = 235 * MiB;
constexpr int CW_BAR = 4096;
constexpr int CW_MOD = 131072;
static_assert((CW_MOD + 4 * 6144) * 4 <= (int)CTL_ZERO_BYTES, "ctl map");

constexpr int RING_OFF = 0, RING_BYTES = 131072;
constexpr int LDSCTL_OFF = RING_BYTES, MISC_OFF = LDSCTL_OFF + 320;
constexpr int LDS_BYTES = 147456;

#define GAS __attribute__((address_space(1)))
#define LAS __attribute__((address_space(3)))
typedef unsigned short bf16;
typedef unsigned v4u __attribute__((ext_vector_type(4)));
typedef unsigned v2u __attribute__((ext_vector_type(2)));
typedef float f32x4 __attribute__((ext_vector_type(4)));
typedef float f32x16 __attribute__((ext_vector_type(16)));
typedef short bf16x8 __attribute__((ext_vector_type(8)));
typedef short s16x4 __attribute__((ext_vector_type(4)));
typedef GAS unsigned gu32;
#define RLX_AGENT __ATOMIC_RELAXED, __HIP_MEMORY_SCOPE_AGENT
#define LDS_WAIT() asm volatile("s_waitcnt lgkmcnt(0)" ::: "memory")
#define VM_WAIT() asm volatile("s_waitcnt vmcnt(0)" ::: "memory")
__device__ __forceinline__ unsigned f2bf(float f) { unsigned u = __builtin_bit_cast(unsigned, f); return (u + 0x7fffu + ((u >> 16) & 1u)) >> 16; }
__device__ __forceinline__ unsigned pk2(float lo, float hi) { return f2bf(lo) | (f2bf(hi) << 16); }
__device__ __forceinline__ float bf2f(unsigned short h) { return __builtin_bit_cast(float, (unsigned)h << 16); }
__device__ __forceinline__ float bflo(unsigned w) { return __builtin_bit_cast(float, w << 16); }
__device__ __forceinline__ float bfhi(unsigned w) { return __builtin_bit_cast(float, w & 0xffff0000u); }
__device__ __forceinline__ float fexp(float x) { return __builtin_amdgcn_exp2f(x * LOG2E); }
__device__ __forceinline__ float silu1(float v) { return v * __builtin_amdgcn_rcpf(1.0f + __builtin_amdgcn_exp2f(-LOG2E * v)); }

#define XB_TMO      128
#define XB_XCNT(j)  (256  + 64 * (j))
#define XB_XSUB(j)  (1280 + 64 * (j))
#define XB_XGEN(j)  (2304 + 64 * (j))
#define XB_TOP      3328
#define XB_TOPGEN   3392
#define XCD_BAR_WORDS 3456
#define XB_SPIN_CAP (1u << 18)

__device__ __forceinline__ unsigned xb_ld(unsigned* p)              { return __hip_atomic_load(p, __ATOMIC_RELAXED, __HIP_MEMORY_SCOPE_AGENT); }
__device__ __forceinline__ unsigned xb_add(unsigned* p, unsigned v) { return __hip_atomic_fetch_add(p, v, __ATOMIC_RELAXED, __HIP_MEMORY_SCOPE_AGENT); }
__device__ __forceinline__ unsigned xb_xcc_id() { return (unsigned)__builtin_amdgcn_s_getreg((3 << 11) | 20) & 0xFu; }
#define XB_SPIN(cond, bar) do { unsigned _sp = 0; while (cond) { __builtin_amdgcn_s_sleep(1); \
    if ((++_sp & 255u) == 0u) { if (xb_ld(&(bar)[XB_TMO])) break; if (_sp > XB_SPIN_CAP) { atomicAdd(&(bar)[XB_TMO], 1u); break; } } } } while (0)

struct XcdBarrier {
    unsigned* bar; unsigned x;
    volatile LAS unsigned* st;
};

__device__ __forceinline__ XcdBarrier xcd_barrier_post(unsigned* bar, volatile LAS unsigned* st) {
    XcdBarrier b; b.bar = bar; b.x = xb_xcc_id(); b.st = st;
    if (threadIdx.x == 0) (void)xb_add(&bar[XB_XCNT(b.x)], 1u);
    return b;
}
__device__ __forceinline__ void xcd_barrier_complete(unsigned* bar, unsigned x, unsigned& nloc, unsigned& nx) {
    const unsigned G = gridDim.x * gridDim.y * gridDim.z;
    unsigned sum, cnt, mine, sp = 0u;
    for (;;) {
        sum = 0u; cnt = 0u; mine = 0u;
#pragma unroll
        for (unsigned j = 0; j < 16; ++j) { const unsigned c = xb_ld(&bar[XB_XCNT(j)]); sum += c; cnt += (c > 0u) ? 1u : 0u; mine = (j == x) ? c : mine; }
        if (sum == G) break;
        __builtin_amdgcn_s_sleep(1);
        if ((++sp & 255u) == 0u) { if (xb_ld(&bar[XB_TMO])) break; if (sp > XB_SPIN_CAP) { atomicAdd(&bar[XB_TMO], 1u); break; } }
    }
    nloc = mine > 0u ? mine : 1u; nx = cnt > 0u ? cnt : 1u;
}

__device__ __forceinline__ void xcd_barrier(const XcdBarrier& b) {
    asm volatile("s_waitcnt vmcnt(0)" ::: "memory");
    __syncthreads();
    if (threadIdx.x == 0) {
        unsigned* bar = b.bar;
        __builtin_amdgcn_s_waitcnt(0);
        unsigned nloc = b.st[0], nx = b.st[1];
        if (nloc == 0u) { xcd_barrier_complete(bar, b.x, nloc, nx); b.st[0] = nloc; b.st[1] = nx; }
        const unsigned old = xb_add(&bar[XB_XSUB(b.x)], 1u);
        const unsigned gen = old / nloc;
        if (old + 1u == (gen + 1u) * nloc) {
            __builtin_amdgcn_fence(__ATOMIC_RELEASE, "agent");
            asm volatile("s_waitcnt vmcnt(0)" ::: "memory");
            const unsigned og = xb_add(&bar[XB_TOP], 1u);
            const unsigned tg = og / nx;
            if (og + 1u == (tg + 1u) * nx) xb_add(&bar[XB_TOPGEN], 1u);
            else XB_SPIN(xb_ld(&bar[XB_TOPGEN]) == tg, bar);
            __builtin_amdgcn_fence(__ATOMIC_ACQUIRE, "agent");
            xb_add(&bar[XB_XGEN(b.x)], 1u);
            asm volatile("s_waitcnt vmcnt(0)" ::: "memory");
        } else {
            XB_SPIN(xb_ld(&bar[XB_XGEN(b.x)]) == gen, bar);
            __builtin_amdgcn_fence(__ATOMIC_ACQUIRE, "agent");
            asm volatile("s_waitcnt vmcnt(0)" ::: "memory");
        }
    }
    __syncthreads();
}

struct Frame {
    LAS unsigned char* lds;
    volatile LAS unsigned* MISC;
    gu32* ctl;
    int tid, lane, wave;
    int vcu, G;
    const float *x, *c, *norm_g, *w_ada, *b_ada, *w_in, *q_g, *k_g, *rel_bias, *lower_bounds, *hg_g, *w_out;
    float* out;
    float* mod;
    bf16 *WIN, *WOUT, *HB, *MIX, *PROJ, *UT, *SALL; float* DL;
};

__device__ __forceinline__ float wave_sum(float v) {
#pragma unroll
    for (int o = 1; o < 64; o <<= 1) v += __shfl_xor(v, o);
    return v;
}
__device__ __forceinline__ void p0_transpose_item(const float* W, int K, int N, bf16* WT, LAS float* scr, int item, int lane) {
    const int nblk = N / 32, kb = item / nblk, nb = item % nblk, k0 = 64 * kb, n0 = 32 * nb;
#pragma unroll 8
    for (int i = 0; i < 32; ++i) { const int kk = 2 * i + (lane >> 5); scr[kk * 33 + (lane & 31)] = W[(size_t)(k0 + kk) * N + n0 + (lane & 31)]; }
    LDS_WAIT(); asm volatile("" ::: "memory");
    const int c = lane & 7;
#pragma unroll
    for (int j = 0; j < 4; ++j) { const int n = (lane >> 3) + 8 * j; const LAS float* s = scr + (8 * c) * 33 + n;
        v4u o; o.x = pk2(s[0 * 33], s[1 * 33]); o.y = pk2(s[2 * 33], s[3 * 33]); o.z = pk2(s[4 * 33], s[5 * 33]); o.w = pk2(s[6 * 33], s[7 * 33]);
        *(GAS v4u*)(WT + (size_t)(n0 + n) * K + k0 + 8 * c) = o; }
    LDS_WAIT(); asm volatile("" ::: "memory");
}
template <bool DRY> __device__ __forceinline__ void p0_ada_item(Frame& F, int item) {
    const int kc = item / 24, cc = item % 24, k0 = 64 * kc, col = 256 * cc + 4 * F.lane;
    float ca[4];
#pragma unroll
    for (int b = 0; b < 4; ++b) ca[b] = silu1(F.c[b * DM + k0 + F.lane]);
    f32x4 acc[4];
#pragma unroll
    for (int b = 0; b < 4; ++b) acc[b] = (f32x4){0.f, 0.f, 0.f, 0.f};
    const GAS f32x4* wp = (const GAS f32x4*)(F.w_ada + (size_t)k0 * 6144 + col);
#pragma unroll 16
    for (int k = 0; k < 64; ++k) {
        const f32x4 w = wp[(size_t)k * (6144 / 4)];
#pragma unroll
        for (int b = 0; b < 4; ++b) { const float s = __shfl(ca[b], k); acc[b] += w * s; }
    }
    if (kc == 0) { const f32x4 bv = *(const f32x4*)(F.b_ada + col);
#pragma unroll
        for (int b = 0; b < 4; ++b) acc[b] += bv; }
#pragma unroll
    for (int b = 0; b < 4; ++b)
#pragma unroll
        for (int i = 0; i < 4; ++i) { if (DRY) asm volatile("" :: "v"(acc[b][i])); else __hip_atomic_fetch_add(F.mod + b * 6144 + col + i, acc[b][i], RLX_AGENT); }
}
__device__ __forceinline__ void p0_prologue(Frame& F) {
    LAS float* scr = (LAS float*)(F.lds + RING_OFF + F.wave * 16384);
    const int gw = F.vcu * NWAVES + F.wave, NGW = F.G * NWAVES;
    constexpr int I_ADA = 32 * 24, I_IN = (DM / 64) * (NIN / 32), I_OUT = (DM / 64) * (DM / 32);
    constexpr int NITEMS = I_ADA + I_IN + I_OUT;
    for (int rep = 0; rep < REP0T; ++rep)
    for (int it = gw; it < NITEMS; it += NGW) {
        int r = it;
        if (r < I_ADA) { if (rep == 0) { for (int q = 0; q < REP0A; ++q) p0_ada_item<true>(F, r); p0_ada_item<false>(F, r); } continue; } r -= I_ADA;
        if (r < I_IN) { p0_transpose_item(F.w_in, DM, NIN, F.WIN, scr, r, F.lane); continue; } r -= I_IN;
        p0_transpose_item(F.w_out, DM, DM, F.WOUT, scr, r, F.lane);
    }
}
__device__ __forceinline__ void p1_rows(Frame& F) {
    const int gw = F.vcu * NWAVES + F.wave, NGW = F.G * NWAVES;
    for (int m = gw; m < MROWS; m += NGW) {
        const int b = m / SEQ;
        const GAS f32x4* xr = (const GAS f32x4*)(F.x + (size_t)m * DM) + F.lane;
        f32x4 v[8]; float s = 0.f;
#pragma unroll
        for (int j = 0; j < 8; ++j) { v[j] = xr[64 * j]; s += (v[j].x * v[j].x + v[j].y * v[j].y) + (v[j].z * v[j].z + v[j].w * v[j].w); }
        const float rinv = 1.0f / sqrtf(wave_sum(s) * (1.f / DM) + EPS);
        const GAS f32x4* gp = (const GAS f32x4*)F.norm_g + F.lane;
        const GAS f32x4* shp = (const GAS f32x4*)(F.mod + b * 6144) + F.lane;
        const GAS f32x4* scp = (const GAS f32x4*)(F.mod + b * 6144 + DM) + F.lane;
        GAS unsigned long long* o8 = (GAS unsigned long long*)(F.HB + (size_t)m * DM) + F.lane;
#pragma unroll
        for (int j = 0; j < 8; ++j) { const f32x4 g = gp[64 * j], sh = shp[64 * j], sc = scp[64 * j];
            const f32x4 hv = (v[j] * rinv) * g * (sc + 1.0f) + sh;
            o8[64 * j] = (unsigned long long)pk2(hv.x, hv.y) | ((unsigned long long)pk2(hv.z, hv.w) << 32); }
    }
}

template <bool DRY> __device__ __forceinline__ void p3_qknorm(Frame& F) {
    const int gw = F.vcu * NWAVES + F.wave, NGW = F.G * NWAVES;
    const int seg = F.lane >> 4, l16 = F.lane & 15;
    for (int it = gw; it < MROWS * 4; it += NGW) {
        const int m = it >> 2, g = it & 3;
        const int col = (g * 4 + seg) * 128 + l16 * 8;
        bf16* p = F.PROJ + (size_t)m * LDP + col;
        const v4u w = *(const GAS v4u*)p;
        float v[8] = {bflo(w.x), bfhi(w.x), bflo(w.y), bfhi(w.y), bflo(w.z), bfhi(w.z), bflo(w.w), bfhi(w.w)};
        float ss = 0.f;
#pragma unroll
        for (int i = 0; i < 8; ++i) ss += v[i] * v[i];
        ss += __shfl_xor(ss, 1); ss += __shfl_xor(ss, 2); ss += __shfl_xor(ss, 4); ss += __shfl_xor(ss, 8);
        float r = 1.0f / sqrtf(ss * (1.f / DH) + EPS);
        const bool isq = col < 1024;
        if (isq) r *= 0.08838834764831845f * LOG2E;
        const float* gp = (isq ? F.q_g : F.k_g) + l16 * 8;
        const f32x4 g0 = *(const f32x4*)gp, g1 = *(const f32x4*)(gp + 4);
        v4u o; o.x = pk2(v[0] * r * g0.x, v[1] * r * g0.y); o.y = pk2(v[2] * r * g0.z, v[3] * r * g0.w);
        o.z = pk2(v[4] * r * g1.x, v[5] * r * g1.y); o.w = pk2(v[6] * r * g1.z, v[7] * r * g1.w);
        if (DRY) asm volatile("" :: "v"(o)); else *(GAS v4u*)p = o;
    }
}

constexpr int HP_QT = 0, HP_KT = 17408, HP_KDT = 60928, HP_VT = 79360, HP_AM = 97792, HP_QTOT = 107008, HP_RREF = 109056;
constexpr int QS = 136, TS = 72;
template <bool DRY> __device__ __forceinline__ void hg_prep_item(Frame& F, int item) {
    const int b = item >> 8, n = (item >> 3) & 31, h = item & 7;
    const int tid = F.tid, lane = F.lane, d = tid & 127, qtr = __builtin_amdgcn_readfirstlane(tid >> 7);
    const size_t m0 = (size_t)b * SEQ + (size_t)n * CHUNK;
    LAS bf16* QT = (LAS bf16*)(F.lds + HP_QT); LAS bf16* KT = (LAS bf16*)(F.lds + HP_KT); LAS bf16* KDT = (LAS bf16*)(F.lds + HP_KDT);
    LAS bf16* VT = (LAS bf16*)(F.lds + HP_VT); LAS bf16* AM = (LAS bf16*)(F.lds + HP_AM);
    LAS float* QTOT = (LAS float*)(F.lds + HP_QTOT); LAS float* RREF = (LAS float*)(F.lds + HP_RREF);
    const float l0 = F.lower_bounds[h * 128 + d], l1 = F.lower_bounds[1024 + h * 128 + d];
    const float lb = 1.0f / (1.0f + fexp(l1 - l0)), oml = 1.0f - lb;
    bf16* prow = F.PROJ + (m0 + 16 * qtr) * LDP + h * 128 + d;
    float q[16], kk[16], bb[16]; unsigned short vv[16];
    float run = 0.f;
#pragma unroll
    for (int i = 0; i < 16; ++i) {
        const float fr = bf2f(prow[(size_t)i * LDP + C_GF]); q[i] = bf2f(prow[(size_t)i * LDP + C_GQ]); vv[i] = prow[(size_t)i * LDP + C_GI];
        const float sg = __builtin_amdgcn_rcpf(1.0f + __builtin_amdgcn_exp2f(-LOG2E * fr));
        const float f = lb + oml * sg;
        run += __builtin_amdgcn_logf(f) * 0.6931471805599453f;
        bb[i] = run; kk[i] = oml * (1.0f - sg);
    }
    QTOT[qtr * 128 + d] = run;
    __syncthreads();
    float prefix = 0.f, total = 0.f;
#pragma unroll
    for (int j = 0; j < 4; ++j) { const float t = QTOT[j * 128 + d]; if (j < qtr) prefix += t; total += t; }
#pragma unroll
    for (int i = 0; i < 16; ++i) bb[i] += prefix;
    const float rown = bb[7];
    RREF[qtr * 128 + d] = rown;
    __syncthreads();
    float rr[4];
#pragma unroll
    for (int j = 0; j < 4; ++j) rr[j] = RREF[j * 128 + d];
#pragma unroll
    for (int i = 0; i < 16; ++i) QT[(16 * qtr + i) * QS + d] = (bf16)f2bf(q[i] * fexp(bb[i] - rown));
#pragma unroll
    for (int I = 0; I < 4; ++I) {
        if (I >= qtr) { const int pair = I * (I + 1) / 2 + qtr;
#pragma unroll
            for (int i = 0; i < 16; ++i) KT[pair * (16 * QS) + i * QS + d] = (bf16)f2bf(kk[i] * fexp(rr[I] - bb[i])); }
    }
    { unsigned kw[8], vw[8];
#pragma unroll
      for (int i = 0; i < 8; ++i) { kw[i] = pk2(kk[2 * i] * fexp(total - bb[2 * i]), kk[2 * i + 1] * fexp(total - bb[2 * i + 1])); vw[i] = (unsigned)vv[2 * i] | ((unsigned)vv[2 * i + 1] << 16); }
      LAS v4u* kp = (LAS v4u*)(KDT + d * TS + 16 * qtr); kp[0] = (v4u){kw[0], kw[1], kw[2], kw[3]}; kp[1] = (v4u){kw[4], kw[5], kw[6], kw[7]};
      LAS v4u* vp = (LAS v4u*)(VT + d * TS + 16 * qtr);  vp[0] = (v4u){vw[0], vw[1], vw[2], vw[3]}; vp[1] = (v4u){vw[4], vw[5], vw[6], vw[7]}; }
#pragma unroll
    for (int i = 0; i < 16; ++i) { const bf16 qe_ = (bf16)f2bf(q[i] * fexp(bb[i])); if (DRY) asm volatile("" :: "v"(qe_)); else prow[(size_t)i * LDP + C_GQ] = qe_; }
    if (qtr == 0) { const float dl_ = fexp(total); if (DRY) asm volatile("" :: "v"(dl_)); else F.DL[(size_t)item * 128 + d] = dl_; }
    __syncthreads();
    const int c = lane & 15, g = lane >> 4, w = F.wave;
#pragma unroll
    for (int rep = 0; rep < 2; ++rep) {
        const int idx = w + 8 * rep;
        if (idx < 10) {
            const int I = (idx >= 6) ? 3 : (idx >= 3) ? 2 : (idx >= 1) ? 1 : 0, J = idx - I * (I + 1) / 2;
            f32x4 acc = {0.f, 0.f, 0.f, 0.f};
#pragma unroll
            for (int ks = 0; ks < 4; ++ks) {
                const bf16x8 a = *(const LAS bf16x8*)(KT + idx * (16 * QS) + c * QS + 32 * ks + 8 * g);
                const bf16x8 bq = *(const LAS bf16x8*)(QT + (16 * I + c) * QS + 32 * ks + 8 * g);
                acc = __builtin_amdgcn_mfma_f32_16x16x32_bf16(a, bq, acc, 0, 0, 0);
            }
            if (I == J) {
#pragma unroll
                for (int r = 0; r < 4; ++r) if (4 * g + r > c) acc[r] = 0.f; }
            *(LAS v2u*)(AM + (16 * I + c) * TS + 16 * J + 4 * g) = (v2u){pk2(acc[0], acc[1]), pk2(acc[2], acc[3])};
        } else if (idx < 12) {
            const int I = (idx == 10) ? 0 : 2, J = I + 1;
            *(LAS v2u*)(AM + (16 * I + c) * TS + 16 * J + 4 * g) = (v2u){0u, 0u};
        }
    }
    __syncthreads();
    bf16x8 vf[2];
#pragma unroll
    for (int ks = 0; ks < 2; ++ks) vf[ks] = *(const LAS bf16x8*)(VT + (16 * w + c) * TS + 32 * ks + 8 * g);
#pragma unroll
    for (int tt = 0; tt < 4; ++tt) {
        f32x4 acc = {0.f, 0.f, 0.f, 0.f};
#pragma unroll
        for (int ks = 0; ks < 2; ++ks) { if (ks == 1 && tt < 2) continue;
            const bf16x8 am = *(const LAS bf16x8*)(AM + (16 * tt + c) * TS + 32 * ks + 8 * g);
            acc = __builtin_amdgcn_mfma_f32_16x16x32_bf16(vf[ks], am, acc, 0, 0, 0); }
        { const v2u r_ = (v2u){pk2(acc[0], acc[1]), pk2(acc[2], acc[3])}; if (DRY) asm volatile("" :: "v"(r_)); else *(GAS v2u*)(F.PROJ + (m0 + 16 * tt + c) * LDP + C_GF + h * 128 + 16 * w + 4 * g) = r_; }
    }
#pragma unroll
    for (int dt = 0; dt < 8; ++dt) {
        f32x4 acc = {0.f, 0.f, 0.f, 0.f};
#pragma unroll
        for (int ks = 0; ks < 2; ++ks) {
            const bf16x8 kd = *(const LAS bf16x8*)(KDT + (16 * dt + c) * TS + 32 * ks + 8 * g);
            acc = __builtin_amdgcn_mfma_f32_16x16x32_bf16(kd, vf[ks], acc, 0, 0, 0); }
        { const v2u r_ = (v2u){pk2(acc[0], acc[1]), pk2(acc[2], acc[3])}; if (DRY) asm volatile("" :: "v"(r_)); else *(GAS v2u*)(F.UT + ((size_t)item * 128 + 16 * w + c) * 128 + 16 * dt + 4 * g) = r_; }
    }
    __syncthreads();
}

__device__ __forceinline__ void hg_sscan(Frame& F) {
    for (int vb = F.vcu; vb < BATCH * NH * 8; vb += F.G) {
        const int bh = vb >> 3, sub = vb & 7, b = bh >> 3, h = bh & 7;
        const int e = 16 * sub + (F.tid >> 5), dq = F.tid & 31;
        const size_t offe = (size_t)e * 128 + 4 * dq;
        f32x4 S = {0.f, 0.f, 0.f, 0.f};
#pragma unroll 1
        for (int n0 = 0; n0 < NCH; n0 += 16) {
            v2u uu[16]; f32x4 dl[16];
#pragma unroll
            for (int j = 0; j < 16; ++j) { const size_t item = (size_t)((b << 8) | ((n0 + j) << 3) | h);
                uu[j] = *(const GAS v2u*)(F.UT + item * 16384 + offe); dl[j] = *(const GAS f32x4*)(F.DL + item * 128 + 4 * dq); }
#pragma unroll
            for (int j = 0; j < 16; ++j) { const size_t item = (size_t)((b << 8) | ((n0 + j) << 3) | h);
                *(GAS v2u*)(F.SALL + item * 16384 + offe) = (v2u){pk2(S[0], S[1]), pk2(S[2], S[3])};
                const f32x4 uf = {bflo(uu[j].x), bfhi(uu[j].x), bflo(uu[j].y), bfhi(uu[j].y)};
                S = dl[j] * S + uf; }
        }
    }
}
constexpr int HO_TSZ = 64 * 272, HO_QE = 0, HO_IN = HO_TSZ, HO_GZ = 2 * HO_TSZ, HO_OUT = 3 * HO_TSZ, HO_SSQ = 4 * HO_TSZ;
constexpr int HO_C0 = 8, HO_C1 = 6, HO_CX = 3, HO_NX = 0;
static_assert(HO_C0 + HO_C1 + 6 * HO_CX + HO_NX == 32 && HO_NX <= 6, "item split");
__device__ __forceinline__ void hg_out_items(Frame& F, int bh, int first, int cnt) {
    const int b = bh >> 3, h = bh & 7, w = F.wave, lane = F.lane, tid = F.tid, c = lane & 15, g = lane >> 4, e0 = 16 * w;
    LAS float* SSQ = (LAS float*)(F.lds + HO_SSQ);
    const f32x4 og = *(const f32x4*)(F.hg_g + e0 + 4 * g);
    const int prow = tid >> 4, pch = tid & 15;
    const int pofs = prow * 272 + pch * 16;
#define HO_DECL(S) v4u qreg##S[2], ireg##S[2], zreg##S[2]; bf16x8 sf##S[4];
#define HO_LOADS(S, k) do { const int item_ = (b << 8) | ((first + (k)) << 3) | h; const size_t m0_ = (size_t)b * SEQ + (size_t)(first + (k)) * CHUNK; \
        _Pragma("unroll") for (int j = 0; j < 2; ++j) { const bf16* rp_ = F.PROJ + (m0_ + prow + 32 * j) * LDP + h * 128 + pch * 8; \
            qreg##S[j] = *(const GAS v4u*)(rp_ + C_GQ); ireg##S[j] = *(const GAS v4u*)(rp_ + C_GF); zreg##S[j] = *(const GAS v4u*)(rp_ + C_GZ); } \
        _Pragma("unroll") for (int ks = 0; ks < 4; ++ks) sf##S[ks] = *(const GAS bf16x8*)(F.SALL + ((size_t)item_ * 128 + e0 + c) * 128 + 32 * ks + 8 * g); } while (0)
#define HO_COPYOUT(k) do { const size_t mo_ = (size_t)b * SEQ + (size_t)(first + (k)) * CHUNK; \
        _Pragma("unroll") for (int j = 0; j < 2; ++j) *(GAS v4u*)(F.MIX + (mo_ + prow + 32 * j) * DM + 1024 + h * 128 + pch * 8) = *(const LAS v4u*)(F.lds + HO_OUT + pofs + j * 32 * 272); } while (0)
#define HO_STEP(S, k) do { if ((k) < cnt) { \
        const int buf = (k) & 1; \
        _Pragma("unroll") for (int j = 0; j < 2; ++j) { *(LAS v4u*)(F.lds + HO_QE + pofs + j * 32 * 272) = qreg##S[j]; *(LAS v4u*)(F.lds + HO_IN + pofs + j * 32 * 272) = ireg##S[j]; \
            *(LAS v4u*)(F.lds + HO_GZ + pofs + j * 32 * 272) = zreg##S[j]; } \
        bf16x8 csf[4]; \
        _Pragma("unroll") for (int i = 0; i < 4; ++i) csf[i] = sf##S[i]; \
        if ((k) + 3 < cnt) HO_LOADS(S, (k) + 3); \
        __syncthreads(); \
        if ((k) > 0) HO_COPYOUT((k) - 1); \
        f32x4 o[4]; v2u cgw[4]; \
        _Pragma("unroll") for (int mt = 0; mt < 4; ++mt) { \
            f32x4 acc = {0.f, 0.f, 0.f, 0.f}; \
            _Pragma("unroll") for (int ks = 0; ks < 4; ++ks) { const bf16x8 qf = *(const LAS bf16x8*)(F.lds + HO_QE + (16 * mt + c) * 272 + (32 * ks + 8 * g) * 2); \
                acc = __builtin_amdgcn_mfma_f32_16x16x32_bf16(csf[ks], qf, acc, 0, 0, 0); } \
            const v2u ciw = *(const LAS v2u*)(F.lds + HO_IN + (16 * mt + c) * 272 + (e0 + 4 * g) * 2); \
            cgw[mt] = *(const LAS v2u*)(F.lds + HO_GZ + (16 * mt + c) * 272 + (e0 + 4 * g) * 2); \
            acc[0] += bflo(ciw.x); acc[1] += bfhi(ciw.x); acc[2] += bflo(ciw.y); acc[3] += bfhi(ciw.y); \
            o[mt] = acc; \
            float ss = (acc[0] * acc[0] + acc[1] * acc[1]) + (acc[2] * acc[2] + acc[3] * acc[3]); \
            ss += __shfl_xor(ss, 16); ss += __shfl_xor(ss, 32); \
            if (g == 0) SSQ[buf * 512 + w * 64 + 16 * mt + c] = ss; } \
        __syncthreads(); \
        _Pragma("unroll") for (int mt = 0; mt < 4; ++mt) { \
            float tot = 0.f; \
            _Pragma("unroll") for (int ww = 0; ww < 8; ++ww) tot += SSQ[buf * 512 + ww * 64 + 16 * mt + c]; \
            const float rinv = __builtin_amdgcn_rsqf(tot * (1.f / 128.f) + EPS); \
            const f32x4 v = o[mt] * rinv * og; \
            *(LAS v2u*)(F.lds + HO_OUT + (16 * mt + c) * 272 + (e0 + 4 * g) * 2) = (v2u){pk2(v[0] * bflo(cgw[mt].x), v[1] * bfhi(cgw[mt].x)), pk2(v[2] * bflo(cgw[mt].y), v[3] * bfhi(cgw[mt].y))}; } \
    } } while (0)
    if (cnt <= 0) return;
    HO_DECL(A) HO_DECL(B) HO_DECL(C)
    HO_LOADS(A, 0); if (cnt > 1) HO_LOADS(B, 1); if (cnt > 2) HO_LOADS(C, 2);
#pragma unroll 1
    for (int k0 = 0; k0 < cnt; k0 += 3) { HO_STEP(A, k0); HO_STEP(B, k0 + 1); HO_STEP(C, k0 + 2); }
    __syncthreads();
    HO_COPYOUT(cnt - 1);
#undef HO_DECL
#undef HO_LOADS
#undef HO_COPYOUT
#undef HO_STEP
}

namespace att {
constexpr int SHM_V = 16384, SHM_K = 16384, A_WS = 2 * SHM_V + 2 * SHM_K, A_BIAS = A_WS + NWAVES * 64 * 4, A_END = A_BIAS + 1040;
constexpr float THR2 = 8.0f * LOG2E;
#define KSWZ(row, colB) ((row) * 256 + ((colB) ^ (((row) & 7) << 4)))
#define SBAR() __builtin_amdgcn_sched_barrier(0)
__device__ __forceinline__ int crow(int r, int hi) { return (r & 3) + 8 * (r >> 2) + 4 * hi; }
__device__ __forceinline__ unsigned cvtpk(float lo, float hi) { unsigned r; asm volatile("v_cvt_pk_bf16_f32 %0, %1, %2" : "=v"(r) : "v"(lo), "v"(hi)); return r; }
__device__ __forceinline__ void partialSM(f32x16& p0, f32x16& p1, float& m_reg, float& alpha) {
  float pmax = p0[0];
#pragma unroll
  for (int r = 1; r < 16; ++r) pmax = fmaxf(pmax, p0[r]);
#pragma unroll
  for (int r = 0; r < 16; ++r) pmax = fmaxf(pmax, p1[r]);
  { auto rr = __builtin_amdgcn_permlane32_swap(__float_as_uint(pmax), __float_as_uint(pmax), false, false);
    pmax = fmaxf(__uint_as_float(rr[0]), __uint_as_float(rr[1])); }
  float mn;
  if (__builtin_expect(__all(pmax - m_reg <= THR2), 1)) { mn = m_reg; alpha = 1.f; }
  else { mn = fmaxf(m_reg, pmax); alpha = __builtin_amdgcn_exp2f(m_reg - mn); m_reg = mn; }
#pragma unroll
  for (int r = 0; r < 16; ++r) p0[r] = __builtin_amdgcn_exp2f(p0[r] - mn);
#pragma unroll
  for (int r = 0; r < 16; ++r) p1[r] = __builtin_amdgcn_exp2f(p1[r] - mn);
}
__device__ __forceinline__ void finishSM(f32x16& p0, f32x16& p1, float alpha, float& l_reg, bf16x8& pa0, bf16x8& pa1, bf16x8& pa2, bf16x8& pa3) {
  float ps = 0;
#pragma unroll
  for (int r = 0; r < 16; ++r) ps += p0[r];
#pragma unroll
  for (int r = 0; r < 16; ++r) ps += p1[r];
  { auto rr = __builtin_amdgcn_permlane32_swap(__float_as_uint(ps), __float_as_uint(ps), false, false);
    ps = __uint_as_float(rr[0]) + __uint_as_float(rr[1]); }
  l_reg = l_reg * alpha + ps;
#define PK4(P, BASE, OUT) do { unsigned a0 = cvtpk(P[BASE + 0], P[BASE + 1]), a1 = cvtpk(P[BASE + 2], P[BASE + 3]);   \
    unsigned b0 = cvtpk(P[BASE + 4], P[BASE + 5]), b1 = cvtpk(P[BASE + 6], P[BASE + 7]);                              \
    auto r0 = __builtin_amdgcn_permlane32_swap(a0, b0, false, false); auto r1 = __builtin_amdgcn_permlane32_swap(a1, b1, false, false); \
    v4u w_ = {r0[0], r1[0], r0[1], r1[1]}; OUT = __builtin_bit_cast(bf16x8, w_); } while (0)
  PK4(p0, 0, pa0); PK4(p0, 8, pa1); PK4(p1, 0, pa2); PK4(p1, 8, pa3);
#undef PK4
}
__device__ __forceinline__ void qkt(f32x16& p0, f32x16& p1, const LAS char* Ks, const bf16x8* qr, int r32, int hi) {
  p0 = f32x16{}; p1 = f32x16{};
#pragma unroll
  for (int d0 = 0; d0 < 8; ++d0) { const int cb = (d0 * 16 + hi * 8) * 2;
    const bf16x8 b0 = *(const LAS bf16x8*)(Ks + KSWZ(r32, cb));
    const bf16x8 b1 = *(const LAS bf16x8*)(Ks + KSWZ(32 + r32, cb));
    p0 = __builtin_amdgcn_mfma_f32_32x32x16_bf16(b0, qr[d0], p0, 0, 0, 0);
    p1 = __builtin_amdgcn_mfma_f32_32x32x16_bf16(b1, qr[d0], p1, 0, 0, 0); }
}
__device__ __forceinline__ int v_st(int k, int c) { const int kk = (k & ~0xC) | ((k & 4) << 1) | ((k & 8) >> 1); return ((kk >> 3) * 4 + (c >> 5)) * 512 + ((kk & 7) * 32 + (c & 31)) * 2; }
__device__ __forceinline__ int v_rd_base(int lane) { return ((lane & 3) << 3) | (((lane >> 2) & 3) << 6) | (((lane >> 4) & 1) << 5) | (((lane >> 5) & 1) << 8); }
constexpr int v_rd_off(int d0, int ks, int half) { return d0 * 512 + ks * 4096 + half * 2048; }
template <int OFF> __device__ __forceinline__ s16x4 tr_read(int vb) {
  s16x4 r; asm volatile("ds_read_b64_tr_b16 %0, %1 offset:%2" : "=&v"(r) : "v"(vb), "i"(OFF) : "memory"); return r;
}
template <int D0> __device__ __forceinline__ void pv_one(f32x16& od, int vb, bf16x8 pa0, bf16x8 pa1, bf16x8 pa2, bf16x8 pa3) {
  const s16x4 l0 = tr_read<v_rd_off(D0, 0, 0)>(vb), h0 = tr_read<v_rd_off(D0, 0, 1)>(vb), l1 = tr_read<v_rd_off(D0, 1, 0)>(vb), h1 = tr_read<v_rd_off(D0, 1, 1)>(vb);
  const s16x4 l2 = tr_read<v_rd_off(D0, 2, 0)>(vb), h2 = tr_read<v_rd_off(D0, 2, 1)>(vb), l3 = tr_read<v_rd_off(D0, 3, 0)>(vb), h3 = tr_read<v_rd_off(D0, 3, 1)>(vb);
  asm volatile("s_waitcnt lgkmcnt(0)" ::: "memory"); SBAR();
#define PK(L, H) (bf16x8){L[0], L[1], L[2], L[3], H[0], H[1], H[2], H[3]}
  od = __builtin_amdgcn_mfma_f32_32x32x16_bf16(pa0, PK(l0, h0), od, 0, 0, 0);
  od = __builtin_amdgcn_mfma_f32_32x32x16_bf16(pa1, PK(l1, h1), od, 0, 0, 0);
  od = __builtin_amdgcn_mfma_f32_32x32x16_bf16(pa2, PK(l2, h2), od, 0, 0, 0);
  od = __builtin_amdgcn_mfma_f32_32x32x16_bf16(pa3, PK(l3, h3), od, 0, 0, 0);
#undef PK
}
__device__ __forceinline__ void pv_d0(f32x16* o, int vb, bf16x8 pa0, bf16x8 pa1, bf16x8 pa2, bf16x8 pa3) {
  pv_one<0>(o[0], vb, pa0, pa1, pa2, pa3); pv_one<1>(o[1], vb, pa0, pa1, pa2, pa3); pv_one<2>(o[2], vb, pa0, pa1, pa2, pa3); pv_one<3>(o[3], vb, pa0, pa1, pa2, pa3);
}

__device__ __forceinline__ void attn_unit(int b, int h, int u, const bf16* PROJ, bf16* MIX, const float* rel_bias, LAS unsigned char* lds) {
  const int tid = threadIdx.x, lane = tid & 63, r32 = lane & 31, hi = lane >> 5; const int wid = __builtin_amdgcn_readfirstlane(tid >> 6);
  LAS char* V_lds = (LAS char*)lds; LAS char* K_lds = (LAS char*)lds + 2 * SHM_V;
  LAS float* ws = (LAS float*)(lds + A_WS) + wid * 64; LAS float* li_l = ws; LAS float* al_l = ws + 32;
  LAS float* bl = (LAS float*)(lds + A_BIAS);
  if (tid < 257) { const float far = rel_bias[h * 257 + 256]; bl[tid] = (rel_bias[h * 257 + tid] - far) * LOG2E; }
  float m_reg = -1e30f, l_reg = 0; f32x16 o[4] = {}; bf16x8 qr[8];
  const size_t mrow0 = (size_t)b * SEQ + 256 * u;
  const bf16* Qw = PROJ + (mrow0 + wid * 32 + r32) * LDP + C_AQ + h * 128 + hi * 8;
#pragma unroll
  for (int d0 = 0; d0 < 8; ++d0) qr[d0] = *(const GAS bf16x8*)(Qw + d0 * 16);
  const bf16* Kh = PROJ + (size_t)b * SEQ * LDP + C_AK + h * 128; const bf16* Vh = PROJ + (size_t)b * SEQ * LDP + C_AV + h * 128;
  const int sr = tid >> 4, sc = (tid & 15) * 8, vst0 = v_st(sr, sc), vst1 = v_st(32 + sr, sc);
  const int vb0 = (int)(uintptr_t)V_lds + v_rd_base(lane);
  const int cw = 4 * u + (wid >> 1), kc_lo = (4 * u - 8 > 0) ? 4 * u - 8 : 0, NT = 4 * u + 3 - kc_lo + 1;
  const int qloc = 32 * (wid & 1) + r32;
  bf16x8 vs0, vs1, ks0, ks1;
#define SLOAD(k0) do { vs0 = *(const GAS bf16x8*)(Vh + (size_t)((k0) + sr) * LDP + sc); vs1 = *(const GAS bf16x8*)(Vh + (size_t)((k0) + 32 + sr) * LDP + sc); \
    ks0 = *(const GAS bf16x8*)(Kh + (size_t)((k0) + sr) * LDP + sc); ks1 = *(const GAS bf16x8*)(Kh + (size_t)((k0) + 32 + sr) * LDP + sc); } while (0)
#define SWRITE(bb) do { *(LAS bf16x8*)(V_lds + (bb) * SHM_V + vst0) = vs0; *(LAS bf16x8*)(V_lds + (bb) * SHM_V + vst1) = vs1; const int kc_ = sc * 2; \
    *(LAS bf16x8*)(K_lds + (bb) * SHM_K + KSWZ(sr, kc_)) = ks0; *(LAS bf16x8*)(K_lds + (bb) * SHM_K + KSWZ(32 + sr, kc_)) = ks1; } while (0)
  SLOAD(kc_lo * 64); SWRITE(0); __syncthreads();
  for (int j = 0; j < NT; ++j) {
    const int kc = kc_lo + j, buf = j & 1;
    if (j + 1 < NT) SLOAD((kc + 1) * 64);
    if (kc >= cw - 8 && kc <= cw) {
      f32x16 p0, p1; float alpha; bf16x8 pa0, pa1, pa2, pa3;
      qkt(p0, p1, K_lds + buf * SHM_K, qr, r32, hi);
      const int delta = cw - kc;
      if (delta <= 2) {
        const int base = delta * 64 + qloc + 128;
#pragma unroll
        for (int r = 0; r < 16; ++r) { const int i0 = base - crow(r, hi), i1 = i0 - 32;
          p0[r] += bl[i0 > 256 ? 256 : i0]; p1[r] += bl[i1 > 256 ? 256 : i1]; }
      }
      partialSM(p0, p1, m_reg, alpha);
      if (__any(alpha < 1.f)) { if (hi == 0) al_l[r32] = alpha; asm volatile("s_waitcnt lgkmcnt(0)" ::: "memory");
#pragma unroll
        for (int d = 0; d < 4; ++d)
#pragma unroll
          for (int r = 0; r < 16; ++r) o[d][r] *= al_l[crow(r, hi)]; }
      finishSM(p0, p1, alpha, l_reg, pa0, pa1, pa2, pa3); SBAR();
      pv_d0(o, vb0 + buf * SHM_V, pa0, pa1, pa2, pa3);
    }
    if (j + 1 < NT) SWRITE(buf ^ 1);
    __syncthreads();
  }
#undef SLOAD
#undef SWRITE
  if (hi == 0) li_l[r32] = l_reg; asm volatile("s_waitcnt lgkmcnt(0)" ::: "memory");
  float rli[16];
#pragma unroll
  for (int r = 0; r < 16; ++r) rli[r] = __builtin_amdgcn_rcpf(li_l[crow(r, hi)]);
#pragma unroll
  for (int r = 0; r < 16; ++r) { const size_t row = mrow0 + wid * 32 + crow(r, hi);
#pragma unroll
    for (int d0 = 0; d0 < 4; ++d0) { const float gz = bf2f(PROJ[row * LDP + C_AZ + h * 128 + d0 * 32 + r32]);
      MIX[row * DM + h * 128 + d0 * 32 + r32] = (bf16)f2bf(o[d0][r] * rli[r] * gz); } }
  __syncthreads();
}
#undef KSWZ
#undef SBAR
}

struct Args { const float* in[12]; float* out; unsigned char* ws; int ph_lo, ph_hi, li, pad; };
__global__ void __launch_bounds__(NWAVES * 64, 2) hymba_fwd(Args args) {
    extern __shared__ __attribute__((aligned(16))) unsigned char lds[];
    Frame F;
    F.lds = (LAS unsigned char*)lds;
    F.MISC = (volatile LAS unsigned*)(F.lds + MISC_OFF);
    F.tid = threadIdx.x; F.lane = F.tid & 63; F.wave = __builtin_amdgcn_readfirstlane(F.tid >> 6);
    F.G = gridDim.x; { const int bx = blockIdx.x; F.vcu = (F.G % 8 == 0) ? (bx % 8) * (F.G / 8) + bx / 8 : bx; }
    unsigned char* ws = args.ws;
    F.ctl = (gu32*)(ws + WS_CTL);
    F.x = args.in[0]; F.c = args.in[1]; F.norm_g = args.in[2]; F.w_ada = args.in[3]; F.b_ada = args.in[4]; F.w_in = args.in[5];
    F.q_g = args.in[6]; F.k_g = args.in[7]; F.rel_bias = args.in[8]; F.lower_bounds = args.in[9]; F.hg_g = args.in[10]; F.w_out = args.in[11];
    F.out = args.out; F.mod = (float*)(ws + WS_CTL) + CW_MOD;
    F.WIN = (bf16*)(ws + WS_WIN); F.WOUT = (bf16*)(ws + WS_WOUT); F.HB = (bf16*)(ws + WS_H); F.MIX = (bf16*)(ws + WS_MIX);
    F.PROJ = (bf16*)(ws + WS_PROJ); F.UT = (bf16*)(ws + WS_UT); F.DL = (float*)(ws + WS_DL); F.SALL = (bf16*)(ws + WS_SALL);
    for (int u = F.tid; u < (LDS_BYTES - LDSCTL_OFF) / 4; u += NWAVES * 64) ((LAS unsigned*)(F.lds + LDSCTL_OFF))[u] = 0u;
    __syncthreads();
    XcdBarrier bar; bar.bar = (unsigned*)(F.ctl + CW_BAR); bar.x = 0; bar.st = nullptr;
    if (N_LAUNCHES == 1) bar = xcd_barrier_post((unsigned*)(F.ctl + CW_BAR), F.MISC + 8);
#define GRID_BAR() do { if (N_LAUNCHES == 1) xcd_barrier(bar); } while (0)
    const int lo = args.ph_lo, hi = args.ph_hi;
#define IN(k) (lo <= (k) && (k) < hi)
#define BOTH(k) (IN(k) && IN((k) + 1))

    if (IN(0)) { p0_prologue(F); if (BOTH(0)) GRID_BAR(); }
    if (IN(1)) { for (int rep = 0; rep < REP1; ++rep) p1_rows(F); if (BOTH(1)) GRID_BAR(); }
    if (IN(2)) {
        pg8::Gemm g{F.HB, F.WIN, MROWS, NIN, DM}; pg8::StaticOrder S; S.init(MROWS, NIN, F.G, (int)blockIdx.x);
        pg8::EpiProj E{F.PROJ, LDP};
        for (int rep = 0; rep < REP2; ++rep) { pg8::gemm_phase<pg8::EpiProj, pg8::StaticOrder, true, true>(F.lds + RING_OFF, g, S, E); if (rep + 1 < REP2) GRID_BAR(); }
        if (BOTH(2)) GRID_BAR();
    }
    if (IN(3)) {
        for (int rep = 0; rep < REP3P; ++rep) for (int it = F.vcu; it < BATCH * NCH * NH; it += F.G) hg_prep_item<true>(F, it);
        for (int it = F.vcu; it < BATCH * NCH * NH; it += F.G) hg_prep_item<false>(F, it);
        for (int rep = 0; rep < REP3N; ++rep) p3_qknorm<true>(F);
        p3_qknorm<false>(F);
        if (BOTH(3)) GRID_BAR();
    }
    if (IN(4)) { for (int rep = 0; rep < REPBAR; ++rep) GRID_BAR(); for (int rep = 0; rep < REP4SS; ++rep) hg_sscan(F); if (BOTH(4)) GRID_BAR(); }
    if (IN(5)) {
        { const int i = F.vcu;
            const int bh = i >> 3, u = i & 7;
            const int cnt = (u == 0) ? HO_C0 : (u == 1) ? HO_C1 : (u - 2 < HO_NX) ? HO_CX + 1 : HO_CX;
            const int first = (u == 0) ? 0 : (u == 1) ? HO_C0 : HO_C0 + HO_C1 + HO_CX * (u - 2) + ((u - 2 < HO_NX) ? (u - 2) : HO_NX);
            const bool attn_first = (bh & 1) != 0;
            if (!attn_first) { for (int rep = 0; rep < REP4O; ++rep) { hg_out_items(F, bh, first, cnt); __syncthreads(); } }
            for (int rep = 0; rep < REP4A; ++rep) att::attn_unit(bh >> 3, bh & 7, u, F.PROJ, F.MIX, F.rel_bias, F.lds);
            if (attn_first) { for (int rep = 0; rep < REP4O; ++rep) { hg_out_items(F, bh, first, cnt); __syncthreads(); } }
        }
        if (BOTH(5)) GRID_BAR();
    }
    if (IN(6)) {
        pg8::Gemm g{F.MIX, F.WOUT, MROWS, DM, DM}; pg8::StaticOrder S; S.init(MROWS, DM, F.G, (int)blockIdx.x);
        pg8::EpiOut E{F.x, F.out, F.mod + 2 * DM};
        for (int rep = 0; rep < REP5; ++rep) { pg8::gemm_phase<pg8::EpiOut, pg8::StaticOrder, true, true>(F.lds + RING_OFF, g, S, E); if (rep + 1 < REP5) GRID_BAR(); }
    }
#undef IN
#undef BOTH
#undef GRID_BAR
}

extern "C" void kernel_launch(void* const* d_in, const int* in_sizes, int n_in, void* d_out, int out_size, void* d_ws, size_t ws_size, hipStream_t stream) {
    static int grid = 0;
    if (grid == 0) {
        if (n_in != 12 || in_sizes[0] != MROWS * DM || out_size != MROWS * DM || ws_size < WS_END) {
            fprintf(stderr, "kernel_launch: shape mismatch: n_in %d in0 %d out %d ws %zu (need %zu)\n", n_in, n_in > 0 ? in_sizes[0] : -1, out_size, ws_size, (size_t)WS_END); grid = -1; return; }
        int dev = 0, cus = 0, per_cu = 0;
        if (hipGetDevice(&dev) != hipSuccess || hipDeviceGetAttribute(&cus, hipDeviceAttributeMultiprocessorCount, dev) != hipSuccess) { fprintf(stderr, "kernel_launch: device query failed\n"); grid = -1; return; }
        if (hipFuncSetAttribute((const void*)hymba_fwd, hipFuncAttributeMaxDynamicSharedMemorySize, LDS_BYTES) != hipSuccess) { fprintf(stderr, "kernel_launch: hipFuncSetAttribute failed\n"); grid = -1; return; }
        if (hipOccupancyMaxActiveBlocksPerMultiprocessor(&per_cu, (const void*)hymba_fwd, NWAVES * 64, LDS_BYTES) != hipSuccess || per_cu < 1) {
            fprintf(stderr, "kernel_launch: occupancy query reports %d workgroups per CU; not launching\n", per_cu); (void)hipGetLastError(); grid = -1; return; }
        grid = cus;
        if (grid != 256) { fprintf(stderr, "kernel_launch: built for a 256-CU device (got %d); not launching\n", grid); grid = -1; return; }
    }
    if (grid <= 0) return;
    if (hipMemsetAsync((char*)d_ws + WS_CTL, 0, CTL_ZERO_BYTES, stream) != hipSuccess) { fprintf(stderr, "kernel_launch: memset failed\n"); return; }
    Args a{};
    for (int i = 0; i < 12; ++i) a.in[i] = (const float*)d_in[i];
    a.out = (float*)d_out; a.ws = (unsigned char*)d_ws;
    if (N_LAUNCHES == 1) {
        a.ph_lo = 0; a.ph_hi = PER_PHASE; a.li = 0;
        void* kargs[] = {&a};
        hipError_t e = hipLaunchCooperativeKernel((const void*)hymba_fwd, dim3(grid), dim3(NWAVES * 64), kargs, LDS_BYTES, stream);
        if (e != hipSuccess) fprintf(stderr, "kernel_launch: cooperative launch failed: %s (grid %d)\n", hipGetErrorString(e), grid);
    } else {
        for (int li = 0; li < PER_PHASE; ++li) {
            a.ph_lo = li; a.ph_hi = li + 1; a.li = li;
            hipLaunchKernelGGL(hymba_fwd, dim3(grid), dim3(NWAVES * 64), LDS_BYTES, stream, a);
            const hipError_t le = hipPeekAtLastError();
            if (le != hipSuccess) { fprintf(stderr, "kernel_launch: launch %d failed: %s\n", li, hipGetErrorName(le)); break; }
        }
    }
}
```

```cpp
#include <hip/hip_runtime.h>
#include <cstdio>
#include <cstdint>

#define LDNT(p) __builtin_nontemporal_load(p)

namespace pg8 {
#define PG8_LAS __attribute__((address_space(3)))
typedef unsigned short bf16_t;
typedef short bf16x8 __attribute__((ext_vector_type(8)));
typedef float f32x4 __attribute__((ext_vector_type(4)));
typedef unsigned u32x4 __attribute__((ext_vector_type(4)));
constexpr int BM = 256, BK = 64, HALF = 128, HTB = HALF * BK * 2  , STAGE_BYTES = 8 * HTB, NXCD = 8, WGM = 8;

__host__ __device__ __forceinline__ int lds_byte(int r, int c) { const int st = (r >> 4) * 2 + (c >> 5), rr = r & 15, cc = c & 31, ob = rr * 64 + cc * 2; return st * 1024 + (ob ^ (((ob >> 9) & 1) << 5)); }
__host__ __device__ __forceinline__ void stage_rc(int b, int& R, int& C) { const int st = b / 1024, sb = b % 1024, swz = sb ^ (((sb >> 9) & 1) << 5); R = (st >> 1) * 16 + swz / 64; C = (st & 1) * 32 + (swz % 64) / 2; }
__host__ __device__ __forceinline__ int perm32(int rho) { const int n = rho >> 4, i = rho & 15; return 8 * (i >> 2) + 4 * n + (i & 3); }

struct Unit { int pm, pn; };
struct Gemm { const bf16_t* A; const bf16_t* Bt; int M, N, K; };

struct StaticOrder {
    int nM, nN, nwg, G, c;
    __host__ __device__ void init(int M, int N, int G_, int c_) { nM = M / BM; nN = N / BM; nwg = nM * nN; G = G_; c = c_; }
    __host__ __device__ bool next(int i, Unit& u) const {
        const long L = (long)i * G + c; if (L >= nwg) return false;
        int wgid = (int)L; { const int q = nwg / NXCD, r = nwg % NXCD, xcd = wgid % NXCD, off = wgid / NXCD; wgid = (xcd < r ? xcd * (q + 1) : r * (q + 1) + (xcd - r) * q) + off; }
        const int nig = WGM * nN, gid = wgid / nig, fm = gid * WGM, gsz = (nM - fm) < WGM ? (nM - fm) : WGM;
        u.pm = fm + ((wgid % nig) % gsz); u.pn = (wgid % nig) / gsz; return true;
    }
    __device__ __forceinline__ void a_ready(const Unit&) const {}
    __device__ __forceinline__ void done(const Unit&) const {}
};

__device__ __forceinline__ unsigned cvt_pk_bf16(float lo, float hi) { unsigned r; asm volatile("v_cvt_pk_bf16_f32 %0, %1, %2" : "=v"(r) : "v"(lo), "v"(hi)); return r; }
__device__ __forceinline__ float silu_f(float v) { return v * __builtin_amdgcn_rcpf(1.0f + __builtin_amdgcn_exp2f(-1.4426950408889634f * v)); }
struct EpiProj {
    static constexpr bool PERM = true, AFTER_DRAIN = false;
    bf16_t* O; int ldc;
    __device__ __forceinline__ void operator()(const f32x4 (&acc)[2][2][4][2], const Unit& u, int wr, int wc, int fr, int fq) const {
        const int row0 = u.pm * BM + wr * 64 + fr, col0 = u.pn * BM + wc * 32 + 8 * fq;
        const int grp = u.pn >> 2; const bool act = (grp == 3) || (grp == 4) || (grp == 7);
#pragma unroll
        for (int ai = 0; ai < 2; ++ai)
#pragma unroll
            for (int m = 0; m < 4; ++m) { bf16_t* rowp = O + (size_t)(row0 + ai * HALF + m * 16) * ldc + col0;
#pragma unroll
                for (int bj = 0; bj < 2; ++bj) { f32x4 v0 = acc[ai][bj][m][0], v1 = acc[ai][bj][m][1];
                    if (act) {
#pragma unroll
                        for (int i = 0; i < 4; ++i) { v0[i] = silu_f(v0[i]); v1[i] = silu_f(v1[i]); } }
                    u32x4 w; w.x = cvt_pk_bf16(v0[0], v0[1]); w.y = cvt_pk_bf16(v0[2], v0[3]); w.z = cvt_pk_bf16(v1[0], v1[1]); w.w = cvt_pk_bf16(v1[2], v1[3]);
                    *(u32x4*)(rowp + bj * HALF) = w; } }
    }
};
struct EpiOut {
    static constexpr bool PERM = false, AFTER_DRAIN = false;
    const float* x; float* out; const float* gate;
    __device__ __forceinline__ void operator()(const f32x4 (&acc)[2][2][4][2], const Unit& u, int wr, int wc, int fr, int fq) const {
        const int row0 = u.pm * BM + wr * 64 + fr, col0 = u.pn * BM + wc * 32 + 4 * fq;
        const float* gp = gate + (size_t)(u.pm >> 3) * 6144 + col0;
        f32x4 gv[2][2];
#pragma unroll
        for (int bj = 0; bj < 2; ++bj)
#pragma unroll
            for (int n = 0; n < 2; ++n) gv[bj][n] = *(const f32x4*)(gp + bj * HALF + n * 16);
#pragma unroll
        for (int ai = 0; ai < 2; ++ai)
#pragma unroll
            for (int m = 0; m < 4; ++m) { const size_t off = (size_t)(row0 + ai * HALF + m * 16) * 2048 + col0;
#pragma unroll
                for (int bj = 0; bj < 2; ++bj)
#pragma unroll
                    for (int n = 0; n < 2; ++n) { const f32x4 xv = *(const f32x4*)(x + off + bj * HALF + n * 16);
                        *(f32x4*)(out + off + bj * HALF + n * 16) = xv + gv[bj][n] * acc[ai][bj][m][n]; } }
    }
};

template <class Epi, class Sched, bool ALIGN_EPI = false, bool SP2 = false>
__device__ __forceinline__ void gemm_phase(PG8_LAS unsigned char* lds, const Gemm g, const Sched& S, const Epi& E) {
    const int tid = threadIdx.x, wid = __builtin_amdgcn_readfirstlane(tid >> 6), lane = tid & 63, wr = wid >> 2, wc = wid & 3, fr = lane & 15, fq = lane >> 4;
    const int K = g.K, nt = K / BK;
    unsigned voffA[2], voffB[2];
#pragma unroll
    for (int i = 0; i < 2; ++i) { int R, C; stage_rc(tid * 16 + i * 8192, R, C); const int Rb = Epi::PERM ? ((R & ~31) + perm32(R & 31)) : R;
        voffA[i] = (unsigned)(R * K + C) * 2u; voffB[i] = (unsigned)(Rb * K + C) * 2u; }
    const size_t kstep = (size_t)(BK * 2);
    const size_t hstep = (size_t)HALF * K * 2;
    const size_t tstep = 2 * hstep;
    const unsigned ldsw = (unsigned)wid * 1024u;
    const int aoff = lds_byte(wr * 64 + fr, fq * 8), boff = lds_byte(wc * 32 + fr, fq * 8);
#define PG8_SA(b, h) (((b) * 2 + (h)) * HTB)
#define PG8_SB(b, h) ((4 + (b) * 2 + (h)) * HTB)
#define PG8_STAGE(bufoff, gbase, voff) do { _Pragma("unroll") for (int _i = 0; _i < 2; ++_i) \
        __builtin_amdgcn_global_load_lds((const unsigned*)((const char*)(gbase) + (voff)[_i]), (PG8_LAS unsigned*)(lds + (bufoff) + ldsw + _i * 8192), 16, 0, 0); } while (0)
#define PG8_LDA(dst, b, h) do { _Pragma("unroll") for (int m = 0; m < 4; ++m) _Pragma("unroll") for (int k = 0; k < 2; ++k) dst[m][k] = *(const PG8_LAS bf16x8*)(lds + PG8_SA(b, h) + aoff + m * 2048 + k * 1024); } while (0)
#define PG8_LDB(dst, b, h) do { _Pragma("unroll") for (int n = 0; n < 2; ++n) _Pragma("unroll") for (int k = 0; k < 2; ++k) dst[n][k] = *(const PG8_LAS bf16x8*)(lds + PG8_SB(b, h) + boff + n * 2048 + k * 1024); } while (0)
#define PG8_MMA(ai, bj, At, Bt) do { __builtin_amdgcn_s_setprio(1); _Pragma("unroll") for (int m = 0; m < 4; ++m) _Pragma("unroll") for (int n = 0; n < 2; ++n) _Pragma("unroll") for (int k = 0; k < 2; ++k) \
        acc[ai][bj][m][n] = __builtin_amdgcn_mfma_f32_16x16x32_bf16(Bt[n][k], At[m][k], acc[ai][bj][m][n], 0, 0, 0); __builtin_amdgcn_s_setprio(0); } while (0)
#define PG8_WAIT_V(n) asm volatile("s_waitcnt vmcnt(" #n ")" ::: "memory")
#define PG8_WAIT_L(n) asm volatile("s_waitcnt lgkmcnt(" #n ")" ::: "memory")
#define PG8_BAR __builtin_amdgcn_s_barrier()
#define PG8_SCHED __builtin_amdgcn_sched_barrier(0)
    Unit cur, nxt; int ui = 0;
    if (!S.next(0, cur)) return;
    f32x4 acc[2][2][4][2];
#pragma unroll
    for (int a = 0; a < 2; ++a)
#pragma unroll
        for (int b = 0; b < 2; ++b)
#pragma unroll
            for (int m = 0; m < 4; ++m)
#pragma unroll
                for (int n = 0; n < 2; ++n) acc[a][b][m][n] = (f32x4){0.f, 0.f, 0.f, 0.f};
    bf16x8 At[4][2], B0[2][2], B1[2][2];
    const char* cA = (const char*)g.A + (size_t)cur.pm * tstep; const char* cB = (const char*)g.Bt + (size_t)cur.pn * tstep;
    S.a_ready(cur);
    if constexpr (SP2) {
        PG8_STAGE(PG8_SB(0, 0), cB, voffB); PG8_STAGE(PG8_SB(0, 1), cB + hstep, voffB); PG8_STAGE(PG8_SA(0, 0), cA, voffA); PG8_STAGE(PG8_SA(0, 1), cA + hstep, voffA);
        if (wr == 1) PG8_BAR;
        PG8_WAIT_V(2); PG8_BAR;
        PG8_STAGE(PG8_SB(1, 0), cB + kstep, voffB); PG8_STAGE(PG8_SA(1, 0), cA + kstep, voffA); PG8_STAGE(PG8_SB(1, 1), cB + hstep + kstep, voffB);
        PG8_WAIT_V(6); PG8_BAR;
    } else {
        PG8_STAGE(PG8_SB(0, 0), cB, voffB); PG8_STAGE(PG8_SA(0, 0), cA, voffA); PG8_STAGE(PG8_SB(0, 1), cB + hstep, voffB); PG8_STAGE(PG8_SA(0, 1), cA + hstep, voffA);
        if (wr == 1) PG8_BAR;
        PG8_WAIT_V(4); PG8_BAR;
        PG8_STAGE(PG8_SB(1, 0), cB + kstep, voffB); PG8_STAGE(PG8_SA(1, 0), cA + kstep, voffA); PG8_STAGE(PG8_SB(1, 1), cB + hstep + kstep, voffB);
        PG8_WAIT_V(6); PG8_BAR;
    }
    for (;;) {
        const bool has_next = S.next(ui + 1, nxt);
        const char* nA = has_next ? (const char*)g.A + (size_t)nxt.pm * tstep : cA; const char* nB = has_next ? (const char*)g.Bt + (size_t)nxt.pn * tstep : cB;
        for (int t = 0; t < nt; t += 2) {
            const bool last = (t == nt - 2);
            const char* a1 = cA + (size_t)(t + 1) * kstep;
            const char* a2 = last ? nA : cA + (size_t)(t + 2) * kstep; const char* b2 = last ? nB : cB + (size_t)(t + 2) * kstep;
            const char* a3 = a2 + kstep; const char* b3 = b2 + kstep;
            if (last && has_next) S.a_ready(nxt);
            if constexpr (SP2) {
            PG8_LDB(B0, 0, 0); PG8_LDB(B1, 0, 1); PG8_SCHED; PG8_LDA(At, 0, 0); PG8_STAGE(PG8_SA(1, 1), a1 + hstep, voffA);
            PG8_WAIT_V(8); PG8_WAIT_L(0); PG8_BAR; PG8_MMA(0, 0, At, B0); PG8_MMA(0, 1, At, B1); PG8_BAR; PG8_SCHED;
            PG8_LDA(At, 0, 1); PG8_STAGE(PG8_SB(0, 0), b2, voffB); PG8_STAGE(PG8_SB(0, 1), b2 + hstep, voffB); PG8_STAGE(PG8_SA(0, 0), a2, voffA);
            PG8_WAIT_V(8); PG8_WAIT_L(0); PG8_BAR; PG8_MMA(1, 0, At, B0); PG8_MMA(1, 1, At, B1); PG8_BAR; PG8_SCHED;
            PG8_LDB(B0, 1, 0); PG8_LDB(B1, 1, 1); PG8_SCHED; PG8_LDA(At, 1, 0); PG8_STAGE(PG8_SA(0, 1), a2 + hstep, voffA);
            PG8_WAIT_V(8); PG8_WAIT_L(0); PG8_BAR; PG8_MMA(0, 0, At, B0); PG8_MMA(0, 1, At, B1); PG8_BAR; PG8_SCHED;
            PG8_LDA(At, 1, 1); PG8_STAGE(PG8_SB(1, 0), b3, voffB); PG8_STAGE(PG8_SB(1, 1), b3 + hstep, voffB); PG8_STAGE(PG8_SA(1, 0), a3, voffA);
            PG8_WAIT_V(8); PG8_WAIT_L(0); PG8_BAR; PG8_MMA(1, 0, At, B0); PG8_MMA(1, 1, At, B1); PG8_BAR; PG8_SCHED;
            } else {
            PG8_LDB(B0, 0, 0); PG8_SCHED; PG8_LDA(At, 0, 0); PG8_STAGE(PG8_SA(1, 1), a1 + hstep, voffA);
            PG8_WAIT_L(8); PG8_BAR; PG8_WAIT_L(0); PG8_MMA(0, 0, At, B0); PG8_BAR; PG8_SCHED;
            PG8_LDB(B1, 0, 1); PG8_STAGE(PG8_SB(0, 0), b2, voffB);
            PG8_BAR; PG8_WAIT_L(0); PG8_MMA(0, 1, At, B1); PG8_BAR;
            PG8_LDA(At, 0, 1); PG8_STAGE(PG8_SA(0, 0), a2, voffA);
            PG8_BAR; PG8_WAIT_L(0); PG8_MMA(1, 0, At, B0); PG8_BAR; PG8_SCHED;
            PG8_STAGE(PG8_SB(0, 1), b2 + hstep, voffB);
            PG8_WAIT_V(6); PG8_BAR; PG8_MMA(1, 1, At, B1); PG8_BAR;
            PG8_LDB(B0, 1, 0); PG8_SCHED; PG8_LDA(At, 1, 0); PG8_STAGE(PG8_SA(0, 1), a2 + hstep, voffA);
            PG8_WAIT_L(8); PG8_BAR; PG8_WAIT_L(0); PG8_MMA(0, 0, At, B0); PG8_BAR; PG8_SCHED;
            PG8_LDB(B1, 1, 1); PG8_STAGE(PG8_SB(1, 0), b3, voffB);
            PG8_BAR; PG8_WAIT_L(0); PG8_MMA(0, 1, At, B1); PG8_BAR;
            PG8_LDA(At, 1, 1); PG8_STAGE(PG8_SA(1, 0), a3, voffA);
            PG8_BAR; PG8_WAIT_L(0); PG8_MMA(1, 0, At, B0); PG8_BAR; PG8_SCHED;
            PG8_STAGE(PG8_SB(1, 1), b3 + hstep, voffB);
            PG8_WAIT_V(6); PG8_BAR; PG8_MMA(1, 1, At, B1); PG8_BAR;
            }
        }
        if constexpr (ALIGN_EPI) { if (wr == 0) PG8_BAR; }
        if constexpr (!Epi::AFTER_DRAIN) { E(acc, cur, wr, wc, fr, fq); S.done(cur); }
        if (!has_next) break;
#pragma unroll
        for (int a = 0; a < 2; ++a)
#pragma unroll
            for (int b = 0; b < 2; ++b)
#pragma unroll
                for (int m = 0; m < 4; ++m)
#pragma unroll
                    for (int n = 0; n < 2; ++n) acc[a][b][m][n] = (f32x4){0.f, 0.f, 0.f, 0.f};
        cur = nxt; cA = nA; cB = nB; ++ui;
        if constexpr (ALIGN_EPI) { if (wr == 1) PG8_BAR; }
    }
    PG8_WAIT_V(0);
    if constexpr (!ALIGN_EPI) { if (wr == 0) PG8_BAR; }
    PG8_BAR;
    if constexpr (Epi::AFTER_DRAIN) { E.fused(acc, cur, wr, wc, fr, fq, lds, wid, lane); S.done(cur); }
#undef PG8_SA
#undef PG8_SB
#undef PG8_STAGE
#undef PG8_LDA
#undef PG8_LDB
#undef PG8_MMA
#undef PG8_WAIT_V
#undef PG8_WAIT_L
#undef PG8_BAR
#undef PG8_SCHED
}
}

constexpr int NWAVES = 8;
constexpr int DM = 2048, BATCH = 4, SEQ = 2048, MROWS = BATCH * SEQ, NIN = 8192, CHUNK = 64, NCH = SEQ / CHUNK, NH = 8, DH = 128;
constexpr int LDP = NIN;
constexpr int C_AQ = 0, C_AK = 1024, C_AV = 2048, C_AZ = 3072, C_GQ = 4096, C_GF = 5120, C_GI = 6144, C_GZ = 7168;
constexpr float EPS = 1e-6f, LOG2E = 1.4426950408889634f;

constexpr size_t MiB = 1u << 20;
constexpr size_t WS_CTL = 0, CTL_ZERO_BYTES = 1 * MiB;
constexpr size_t WS_WIN = 2 * MiB;
constexpr size_t WS_UT = 2 * MiB;
constexpr size_t WS_WOUT = 34 * MiB;
constexpr size_t WS_H = 42 * MiB;
constexpr size_t WS_MIX = 42 * MiB;
constexpr size_t WS_PROJ = 74 * MiB;
constexpr size_t WS_DL = 202 * MiB;
constexpr size_t WS_END = 203 * MiB;
constexpr int CW_BAR = 4096;
constexpr int CW_MOD = 131072;
static_assert((CW_MOD + 4 * 6144) * 4 <= (int)CTL_ZERO_BYTES, "ctl map");

constexpr int RING_OFF = 0, RING_BYTES = 131072;
constexpr int LDSCTL_OFF = RING_BYTES, MISC_OFF = LDSCTL_OFF + 320;
constexpr int LDS_BYTES = 147456;

#define GAS __attribute__((address_space(1)))
#define LAS __attribute__((address_space(3)))
typedef unsigned short bf16;
typedef unsigned v4u __attribute__((ext_vector_type(4)));
typedef unsigned v2u __attribute__((ext_vector_type(2)));
typedef float f32x4 __attribute__((ext_vector_type(4)));
typedef float f32x16 __attribute__((ext_vector_type(16)));
typedef short bf16x8 __attribute__((ext_vector_type(8)));
typedef short s16x4 __attribute__((ext_vector_type(4)));
typedef GAS unsigned gu32;
#define RLX_AGENT __ATOMIC_RELAXED, __HIP_MEMORY_SCOPE_AGENT
#define LDS_WAIT() asm volatile("s_waitcnt lgkmcnt(0)" ::: "memory")
#define VM_WAIT() asm volatile("s_waitcnt vmcnt(0)" ::: "memory")
typedef float f32x2_t __attribute__((ext_vector_type(2))); typedef __bf16 bf16x2_t __attribute__((ext_vector_type(2)));
__device__ __forceinline__ unsigned pk2(float lo, float hi) { f32x2_t v = {lo, hi}; bf16x2_t b = __builtin_convertvector(v, bf16x2_t); return __builtin_bit_cast(unsigned, b); }
__device__ __forceinline__ unsigned f2bf(float f) { return pk2(f, f) & 0xffffu; }
__device__ __forceinline__ float bf2f(unsigned short h) { return __builtin_bit_cast(float, (unsigned)h << 16); }
__device__ __forceinline__ float bflo(unsigned w) { return __builtin_bit_cast(float, w << 16); }
__device__ __forceinline__ float bfhi(unsigned w) { return __builtin_bit_cast(float, w & 0xffff0000u); }
__device__ __forceinline__ float fexp(float x) { return __builtin_amdgcn_exp2f(x * LOG2E); }
__device__ __forceinline__ float silu1(float v) { return v * __builtin_amdgcn_rcpf(1.0f + __builtin_amdgcn_exp2f(-LOG2E * v)); }

#define XB_TMO      128
#define XB_XCNT(j)  (256  + 64 * (j))
#define XB_XSUB(j)  (1280 + 64 * (j))
#define XB_XGEN(j)  (2304 + 64 * (j))
#define XB_TOP      3328
#define XB_TOPGEN   3392
#define XCD_BAR_WORDS 3456
#define XB_SPIN_CAP (1u << 18)

__device__ __forceinline__ unsigned xb_ld(unsigned* p)              { return __hip_atomic_load(p, __ATOMIC_RELAXED, __HIP_MEMORY_SCOPE_AGENT); }
__device__ __forceinline__ unsigned xb_add(unsigned* p, unsigned v) { return __hip_atomic_fetch_add(p, v, __ATOMIC_RELAXED, __HIP_MEMORY_SCOPE_AGENT); }
__device__ __forceinline__ unsigned xb_xcc_id() { return (unsigned)__builtin_amdgcn_s_getreg((3 << 11) | 20) & 0xFu; }
#define XB_SPIN(cond, bar) do { unsigned _sp = 0; while (cond) { __builtin_amdgcn_s_sleep(1); \
    if ((++_sp & 255u) == 0u) { if (xb_ld(&(bar)[XB_TMO])) break; if (_sp > XB_SPIN_CAP) { atomicAdd(&(bar)[XB_TMO], 1u); break; } } } } while (0)

struct XcdBarrier {
    unsigned* bar; unsigned x;
    volatile LAS unsigned* st;
};

__device__ __forceinline__ XcdBarrier xcd_barrier_post(unsigned* bar, volatile LAS unsigned* st) {
    XcdBarrier b; b.bar = bar; b.x = xb_xcc_id(); b.st = st;
    if (threadIdx.x == 0) (void)xb_add(&bar[XB_XCNT(b.x)], 1u);
    return b;
}
__device__ __forceinline__ void xcd_barrier_complete(unsigned* bar, unsigned x, unsigned& nloc, unsigned& nx) {
    const unsigned G = gridDim.x * gridDim.y * gridDim.z;
    unsigned sum, cnt, mine, sp = 0u;
    for (;;) {
        sum = 0u; cnt = 0u; mine = 0u;
#pragma unroll
        for (unsigned j = 0; j < 16; ++j) { const unsigned c = xb_ld(&bar[XB_XCNT(j)]); sum += c; cnt += (c > 0u) ? 1u : 0u; mine = (j == x) ? c : mine; }
        if (sum == G) break;
        __builtin_amdgcn_s_sleep(1);
        if ((++sp & 255u) == 0u) { if (xb_ld(&bar[XB_TMO])) break; if (sp > XB_SPIN_CAP) { atomicAdd(&bar[XB_TMO], 1u); break; } }
    }
    nloc = mine > 0u ? mine : 1u; nx = cnt > 0u ? cnt : 1u;
}

__device__ __forceinline__ void xcd_barrier(const XcdBarrier& b) {
    asm volatile("s_waitcnt vmcnt(0)" ::: "memory");
    __syncthreads();
    if (threadIdx.x == 0) {
        unsigned* bar = b.bar;
        __builtin_amdgcn_s_waitcnt(0);
        unsigned nloc = b.st[0], nx = b.st[1];
        if (nloc == 0u) { xcd_barrier_complete(bar, b.x, nloc, nx); b.st[0] = nloc; b.st[1] = nx; }
        const unsigned old = xb_add(&bar[XB_XSUB(b.x)], 1u);
        const unsigned gen = old / nloc;
        if (old + 1u == (gen + 1u) * nloc) {
            __builtin_amdgcn_fence(__ATOMIC_RELEASE, "agent");
            asm volatile("s_waitcnt vmcnt(0)" ::: "memory");
            const unsigned og = xb_add(&bar[XB_TOP], 1u);
            const unsigned tg = og / nx;
            if (og + 1u == (tg + 1u) * nx) xb_add(&bar[XB_TOPGEN], 1u);
            else XB_SPIN(xb_ld(&bar[XB_TOPGEN]) == tg, bar);
            __builtin_amdgcn_fence(__ATOMIC_ACQUIRE, "agent");
            xb_add(&bar[XB_XGEN(b.x)], 1u);
            asm volatile("s_waitcnt vmcnt(0)" ::: "memory");
        } else {
            XB_SPIN(xb_ld(&bar[XB_XGEN(b.x)]) == gen, bar);
            __builtin_amdgcn_fence(__ATOMIC_ACQUIRE, "agent");
            asm volatile("s_waitcnt vmcnt(0)" ::: "memory");
        }
    }
    __syncthreads();
}


struct Frame {
    LAS unsigned char* lds;
    volatile LAS unsigned* MISC;
    gu32* ctl;
    int tid, lane, wave;
    int vcu, G;
    const float *x, *c, *norm_g, *w_ada, *b_ada, *w_in, *q_g, *k_g, *rel_bias, *lower_bounds, *hg_g, *w_out;
    float* out;
    float* mod;
    bf16 *WIN, *WOUT, *HB, *MIX, *PROJ, *UT; float* DL;
};

__device__ __forceinline__ float wave_sum(float v) {
#pragma unroll
    for (int o = 1; o < 64; o <<= 1) v += __shfl_xor(v, o);
    return v;
}
__device__ __forceinline__ void p0_ada_block(Frame& F, int blk) {
    const int cc = blk % 24, kblk = blk / 24, k0 = 256 * kblk + 32 * F.wave, col = 256 * cc + 4 * F.lane;
    float ca[4];
#pragma unroll
    for (int b = 0; b < 4; ++b) ca[b] = silu1(F.c[b * DM + k0 + (F.lane & 31)]);
    f32x4 acc[4];
#pragma unroll
    for (int b = 0; b < 4; ++b) acc[b] = (f32x4){0.f, 0.f, 0.f, 0.f};
    const GAS f32x4* wp = (const GAS f32x4*)(F.w_ada + (size_t)k0 * 6144 + col);
    f32x4 wv[32];
#pragma unroll
    for (int k = 0; k < 32; ++k) wv[k] = LDNT(wp + (size_t)k * (6144 / 4));
#pragma unroll
    for (int k = 0; k < 32; ++k) {
#pragma unroll
        for (int b = 0; b < 4; ++b) { const float s = __builtin_bit_cast(float, __builtin_amdgcn_readlane(__builtin_bit_cast(int, ca[b]), k)); acc[b] += wv[k] * s; }
    }
    LAS f32x4* red = (LAS f32x4*)(F.lds + RING_OFF);
#pragma unroll
    for (int b = 0; b < 4; ++b) red[(F.wave * 4 + b) * 64 + F.lane] = acc[b];
    __syncthreads();
    if (F.wave < 4) { const int b = F.wave; f32x4 t = red[b * 64 + F.lane];
#pragma unroll
        for (int ww = 1; ww < 8; ++ww) t += red[(ww * 4 + b) * 64 + F.lane];
        if (kblk == 0) t += *(const f32x4*)(F.b_ada + col);
#pragma unroll
        for (int i = 0; i < 4; ++i) __hip_atomic_fetch_add(F.mod + b * 6144 + col + i, t[i], RLX_AGENT); }
    __syncthreads();
}
constexpr int TR_P = 260;
struct TrTile { const float* W; bf16* WT; int K, N, kb, nb; };
__device__ __forceinline__ TrTile p0_tile(const Frame& F, int t) {
    TrTile r; if (t < 1024) { r.W = F.w_in; r.WT = F.WIN; r.K = DM; r.N = NIN; r.kb = t >> 5; r.nb = t & 31; } else { t -= 1024; r.W = F.w_out; r.WT = F.WOUT; r.K = DM; r.N = DM; r.kb = t >> 3; r.nb = t & 7; } return r;
}
__device__ __forceinline__ void p0_tr_load(const TrTile& t, f32x4 (&r)[8], int wave, int lane) {
#pragma unroll
    for (int i = 0; i < 8; ++i) r[i] = LDNT((const GAS f32x4*)(t.W + (size_t)(64 * t.kb + 8 * wave + i) * t.N + 256 * t.nb + 4 * lane));
}
__device__ __forceinline__ void p0_transposes(Frame& F) {
    LAS bf16* scr = (LAS bf16*)(F.lds + RING_OFF);
    const int w = F.wave, lane = F.lane, g = lane >> 4, i16 = lane & 15, q = i16 >> 2, pp = i16 & 3;
    constexpr int NT = 1024 + 256;
    int t = F.vcu; if (t >= NT) return;
    f32x4 cur[8]; TrTile tc = p0_tile(F, t); p0_tr_load(tc, cur, w, lane);
    for (;;) {
        const int tn_ = t + F.G; const bool more = tn_ < NT;
        f32x4 nxt[8]; TrTile tn = tc; if (more) { tn = p0_tile(F, tn_); p0_tr_load(tn, nxt, w, lane); }
#pragma unroll
        for (int i = 0; i < 8; ++i) *(LAS v2u*)(scr + (8 * w + i) * TR_P + 4 * lane) = (v2u){pk2(cur[i].x, cur[i].y), pk2(cur[i].z, cur[i].w)};
        __syncthreads();
#pragma unroll
        for (int j = 0; j < 4; ++j) {
            const int nb16 = 32 * w + 16 * (j & 1), kc = 4 * (j >> 1) + g;
            const LAS bf16* a0 = scr + (8 * kc + q) * TR_P + nb16 + 4 * pp;
            const s16x4 lo = __builtin_bit_cast(s16x4, __builtin_amdgcn_ds_read_tr16_b64_v4i16((LAS s16x4*)a0));
            const s16x4 hi = __builtin_bit_cast(s16x4, __builtin_amdgcn_ds_read_tr16_b64_v4i16((LAS s16x4*)(a0 + 4 * TR_P)));
            const bf16x8 o = {lo[0], lo[1], lo[2], lo[3], hi[0], hi[1], hi[2], hi[3]};
            *(GAS bf16x8*)(tc.WT + (size_t)(256 * tc.nb + nb16 + i16) * tc.K + 64 * tc.kb + 8 * kc) = o;
        }
        __syncthreads();
        if (!more) break;
#pragma unroll
        for (int i = 0; i < 8; ++i) cur[i] = nxt[i];
        tc = tn; t = tn_;
    }
}
__device__ __forceinline__ void p0_prologue(Frame& F) {
    if (F.vcu < 192) p0_ada_block(F, F.vcu);
    p0_transposes(F);
}
__device__ __forceinline__ void p1_rows(Frame& F) {
    const int gw = F.vcu * NWAVES + F.wave, NGW = F.G * NWAVES;
    constexpr int RPW = 4;
    for (int it = gw; it < MROWS / RPW; it += NGW) {
        const int mbase = it * RPW, b = mbase / SEQ;
        f32x4 ga[8], sh[8];
        { const GAS f32x4* gp = (const GAS f32x4*)F.norm_g + F.lane; const GAS f32x4* shp = (const GAS f32x4*)(F.mod + b * 6144) + F.lane; const GAS f32x4* scp = (const GAS f32x4*)(F.mod + b * 6144 + DM) + F.lane;
#pragma unroll
          for (int j = 0; j < 8; ++j) { ga[j] = gp[64 * j] * (scp[64 * j] + 1.0f); sh[j] = shp[64 * j]; } }
        f32x4 v[8];
#pragma unroll
        for (int j = 0; j < 8; ++j) v[j] = LDNT((const GAS f32x4*)(F.x + (size_t)mbase * DM) + F.lane + 64 * j);
#pragma unroll
        for (int r = 0; r < RPW; ++r) {
            f32x4 nv[8];
            if (r + 1 < RPW) {
#pragma unroll
                for (int j = 0; j < 8; ++j) nv[j] = LDNT((const GAS f32x4*)(F.x + (size_t)(mbase + r + 1) * DM) + F.lane + 64 * j); }
            float s = 0.f;
#pragma unroll
            for (int j = 0; j < 8; ++j) s += (v[j].x * v[j].x + v[j].y * v[j].y) + (v[j].z * v[j].z + v[j].w * v[j].w);
            const float rinv = __builtin_amdgcn_rsqf(wave_sum(s) * (1.f / DM) + EPS);
            GAS unsigned long long* o8 = (GAS unsigned long long*)(F.HB + (size_t)(mbase + r) * DM) + F.lane;
#pragma unroll
            for (int j = 0; j < 8; ++j) { const f32x4 hv = (v[j] * rinv) * ga[j] + sh[j];
                o8[64 * j] = (unsigned long long)pk2(hv.x, hv.y) | ((unsigned long long)pk2(hv.z, hv.w) << 32); }
            if (r + 1 < RPW) {
#pragma unroll
                for (int j = 0; j < 8; ++j) v[j] = nv[j]; }
        }
    }
}

constexpr int HP_QT = 0, HP_KT = 17408, HP_KDT = 60928, HP_VT = 79360, HP_AM = 97792, HP_QTOT = 107008, HP_RREF = 109056, HP_QEO = 111104;
constexpr int HP_RAWF = HP_KT, HP_RAWQ = HP_KT + 16384, HP_RAWV = HP_KDT;
constexpr int HP_INO = 0, HP_UTS = 17408, HP_DLT = 128512, HP_PT = 129024, QEP = 136;
constexpr int QS = 136, TS = 72;
static_assert(HP_QEO + 64 * 272 <= 128512 && HP_PT + 512 <= RING_BYTES && HP_UTS + 8 * 16 * 272 <= HP_KDT && HP_RAWQ + 16384 <= HP_KDT, "prep LDS map");
__device__ __forceinline__ void hg_prep_items(Frame& F) {
    const int tid = F.tid, lane = F.lane, c = lane & 15, g = lane >> 4, w = F.wave;
    const int prow = tid >> 4, pch = tid & 15;
    LAS bf16* QT = (LAS bf16*)(F.lds + HP_QT); LAS bf16* KT = (LAS bf16*)(F.lds + HP_KT); LAS bf16* KDT = (LAS bf16*)(F.lds + HP_KDT);
    LAS bf16* VT = (LAS bf16*)(F.lds + HP_VT); LAS bf16* AM = (LAS bf16*)(F.lds + HP_AM);
    LAS float* QTOT = (LAS float*)(F.lds + HP_QTOT);
    LAS bf16* RAWF = (LAS bf16*)(F.lds + HP_RAWF); LAS bf16* RAWQ = (LAS bf16*)(F.lds + HP_RAWQ); LAS bf16* RAWV = (LAS bf16*)(F.lds + HP_RAWV);
    LAS bf16* QEO = (LAS bf16*)(F.lds + HP_QEO);
    v4u rf[2], rq[2], rv[2];
#define HP_LOADS(item_) do { const int b_ = (item_) >> 8, n_ = ((item_) >> 3) & 31, h_ = (item_) & 7; \
        _Pragma("unroll") for (int j = 0; j < 2; ++j) { const bf16* rp_ = F.PROJ + ((size_t)b_ * SEQ + (size_t)n_ * CHUNK + prow + 32 * j) * LDP + h_ * 128 + pch * 8; \
            rf[j] = *(const GAS v4u*)(rp_ + C_GF); rq[j] = *(const GAS v4u*)(rp_ + C_GQ); rv[j] = *(const GAS v4u*)(rp_ + C_GI); } } while (0)
    const int bh_ = F.vcu >> 3, u_ = F.vcu & 7;
    LAS float* DLT = (LAS float*)(F.lds + HP_DLT); LAS float* PT = (LAS float*)(F.lds + HP_PT);
    f32x4 Lst[8];
#pragma unroll
    for (int i = 0; i < 8; ++i) Lst[i] = (f32x4){0.f, 0.f, 0.f, 0.f};
    float Pg[2] = {1.0f, 1.0f};
    float lbv[2], omlv[2];
#pragma unroll
    for (int e = 0; e < 2; ++e) { const float l0 = F.lower_bounds[(bh_ & 7) * 128 + 2 * lane + e], l1 = F.lower_bounds[1024 + (bh_ & 7) * 128 + 2 * lane + e];
        lbv[e] = 1.0f / (1.0f + fexp(l1 - l0)); omlv[e] = 1.0f - lbv[e]; }
    const int item0 = ((bh_ >> 3) << 8) | ((4 * u_) << 3) | (bh_ & 7);
    HP_LOADS(item0);
    for (int jj = 0; jj < 4; ++jj) {
        const int item = item0 + (jj << 3);
        const int b = item >> 8, n = (item >> 3) & 31, h = item & 7;
        const size_t m0 = (size_t)b * SEQ + (size_t)n * CHUNK;
#pragma unroll
        for (int j = 0; j < 2; ++j) { const int o_ = (prow + 32 * j) * 128 + pch * 8;
            *(LAS v4u*)(RAWF + o_) = rf[j]; *(LAS v4u*)(RAWQ + o_) = rq[j]; *(LAS v4u*)(RAWV + o_) = rv[j]; }
        if (jj + 1 < 4) HP_LOADS(item + 8);
        __syncthreads();
        const int gq = w, J = gq >> 1, hf = gq & 1;
        float q[8][2], kk[8][2], ff[8][2]; unsigned vv[8];
#pragma unroll
        for (int i = 0; i < 8; ++i) {
            const int o_ = (8 * gq + i) * 128 + 2 * lane;
            const unsigned fw = *(const LAS unsigned*)(RAWF + o_), qw = *(const LAS unsigned*)(RAWQ + o_); vv[i] = *(const LAS unsigned*)(RAWV + o_);
            const float fr0 = bflo(fw), fr1 = bfhi(fw); q[i][0] = bflo(qw); q[i][1] = bfhi(qw);
            const float sg0 = __builtin_amdgcn_rcpf(1.0f + __builtin_amdgcn_exp2f(-LOG2E * fr0)), sg1 = __builtin_amdgcn_rcpf(1.0f + __builtin_amdgcn_exp2f(-LOG2E * fr1));
            ff[i][0] = lbv[0] + omlv[0] * sg0; ff[i][1] = lbv[1] + omlv[1] * sg1;
            kk[i][0] = omlv[0] * (1.0f - sg0); kk[i][1] = omlv[1] * (1.0f - sg1);
        }
        float ep[8][2], gt[2];
        if (hf == 0) {
#pragma unroll
            for (int e = 0; e < 2; ++e) { ep[7][e] = 1.0f;
#pragma unroll
                for (int i = 6; i >= 0; --i) ep[i][e] = ep[i + 1][e] * ff[i + 1][e];
                gt[e] = ep[0][e] * ff[0][e]; }
        } else {
#pragma unroll
            for (int e = 0; e < 2; ++e) { ep[0][e] = ff[0][e];
#pragma unroll
                for (int i = 1; i < 8; ++i) ep[i][e] = ep[i - 1][e] * ff[i][e];
                gt[e] = ep[7][e]; }
        }
        *(LAS f32x2_t*)(QTOT + gq * 128 + 2 * lane) = (f32x2_t){gt[0], gt[1]};
        float qt[8][2], kt[8][2];
#pragma unroll
        for (int i = 0; i < 8; ++i)
#pragma unroll
            for (int e = 0; e < 2; ++e) { const float rc = __builtin_amdgcn_rcpf(fmaxf(ep[i][e], 1e-30f));
                qt[i][e] = q[i][e] * (hf == 0 ? rc : ep[i][e]); kt[i][e] = kk[i][e] * (hf == 0 ? ep[i][e] : rc); }
        __syncthreads();
        float G[8][2];
#pragma unroll
        for (int j = 0; j < 8; ++j) { const f32x2_t t = *(const LAS f32x2_t*)(QTOT + j * 128 + 2 * lane); G[j][0] = t.x; G[j][1] = t.y; }
        float er[2], xk[2], tot[2];
#pragma unroll
        for (int e = 0; e < 2; ++e) { float a = 1.0f, bq_ = 1.0f;
#pragma unroll
            for (int j = 0; j < 8; ++j) { if (j <= 2 * J) a *= G[j][e]; else bq_ *= G[j][e]; }
            er[e] = a; xk[e] = bq_; tot[e] = a * bq_; }
        const int trow = 8 * gq;
#pragma unroll
        for (int i = 0; i < 8; ++i) *(LAS unsigned*)(QT + (trow + i) * QS + 2 * lane) = pk2(qt[i][0], qt[i][1]);
        { float x0 = 1.0f, x1 = 1.0f;
#pragma unroll
          for (int I = 0; I < 4; ++I) {
              if (I >= J) {
                  if (I > J) { x0 *= G[2 * I - 1][0] * G[2 * I][0]; x1 *= G[2 * I - 1][1] * G[2 * I][1]; }
                  const int pair = I * (I + 1) / 2 + J;
#pragma unroll
                  for (int i = 0; i < 8; ++i) *(LAS unsigned*)(KT + pair * (16 * QS) + (8 * hf + i) * QS + 2 * lane) = pk2(kt[i][0] * x0, kt[i][1] * x1);
              }
          } }
        { v4u k0, k1, v0, v1;
          k0.x = pk2(kt[0][0] * xk[0], kt[1][0] * xk[0]); k0.y = pk2(kt[2][0] * xk[0], kt[3][0] * xk[0]); k0.z = pk2(kt[4][0] * xk[0], kt[5][0] * xk[0]); k0.w = pk2(kt[6][0] * xk[0], kt[7][0] * xk[0]);
          k1.x = pk2(kt[0][1] * xk[1], kt[1][1] * xk[1]); k1.y = pk2(kt[2][1] * xk[1], kt[3][1] * xk[1]); k1.z = pk2(kt[4][1] * xk[1], kt[5][1] * xk[1]); k1.w = pk2(kt[6][1] * xk[1], kt[7][1] * xk[1]);
          v0.x = (vv[0] & 0xffffu) | (vv[1] << 16); v0.y = (vv[2] & 0xffffu) | (vv[3] << 16); v0.z = (vv[4] & 0xffffu) | (vv[5] << 16); v0.w = (vv[6] & 0xffffu) | (vv[7] << 16);
          v1.x = (vv[0] >> 16) | (vv[1] & 0xffff0000u); v1.y = (vv[2] >> 16) | (vv[3] & 0xffff0000u); v1.z = (vv[4] >> 16) | (vv[5] & 0xffff0000u); v1.w = (vv[6] >> 16) | (vv[7] & 0xffff0000u);
          *(LAS v4u*)(KDT + (2 * lane) * TS + trow) = k0; *(LAS v4u*)(KDT + (2 * lane + 1) * TS + trow) = k1;
          *(LAS v4u*)(VT + (2 * lane) * TS + trow) = v0;  *(LAS v4u*)(VT + (2 * lane + 1) * TS + trow) = v1; }
#pragma unroll
        for (int i = 0; i < 8; ++i) *(LAS unsigned*)(QEO + (trow + i) * QEP + 2 * lane) = pk2(qt[i][0] * er[0], qt[i][1] * er[1]);
        if (gq == 0) { *(LAS f32x2_t*)(DLT + 2 * lane) = (f32x2_t){tot[0], tot[1]}; *(LAS f32x2_t*)(PT + 2 * lane) = (f32x2_t){Pg[0], Pg[1]}; }
        Pg[0] *= tot[0]; Pg[1] *= tot[1];
        __syncthreads();
#pragma unroll
        for (int rep = 0; rep < 2; ++rep) {
            const int idx = w + 8 * rep;
            if (idx < 10) {
                const int I = (idx >= 6) ? 3 : (idx >= 3) ? 2 : (idx >= 1) ? 1 : 0, J = idx - I * (I + 1) / 2;
                f32x4 acc = {0.f, 0.f, 0.f, 0.f};
#pragma unroll
                for (int ks = 0; ks < 4; ++ks) {
                    const bf16x8 a = *(const LAS bf16x8*)(KT + idx * (16 * QS) + c * QS + 32 * ks + 8 * g);
                    const bf16x8 bq = *(const LAS bf16x8*)(QT + (16 * I + c) * QS + 32 * ks + 8 * g);
                    acc = __builtin_amdgcn_mfma_f32_16x16x32_bf16(a, bq, acc, 0, 0, 0);
                }
                if (I == J) {
#pragma unroll
                    for (int r = 0; r < 4; ++r) if (4 * g + r > c) acc[r] = 0.f; }
                *(LAS v2u*)(AM + (16 * I + c) * TS + 16 * J + 4 * g) = (v2u){pk2(acc[0], acc[1]), pk2(acc[2], acc[3])};
            } else if (idx < 12) {
                const int I = (idx == 10) ? 0 : 2, J = I + 1;
                *(LAS v2u*)(AM + (16 * I + c) * TS + 16 * J + 4 * g) = (v2u){0u, 0u};
            }
        }
        __syncthreads();
        bf16x8 vf[2];
#pragma unroll
        for (int ks = 0; ks < 2; ++ks) vf[ks] = *(const LAS bf16x8*)(VT + (16 * w + c) * TS + 32 * ks + 8 * g);
        bf16x8 lf[4];
#pragma unroll
        for (int ks = 0; ks < 4; ++ks) { v4u t_; t_.x = pk2(Lst[2 * ks][0], Lst[2 * ks][1]); t_.y = pk2(Lst[2 * ks][2], Lst[2 * ks][3]);
            t_.z = pk2(Lst[2 * ks + 1][0], Lst[2 * ks + 1][1]); t_.w = pk2(Lst[2 * ks + 1][2], Lst[2 * ks + 1][3]); lf[ks] = __builtin_bit_cast(bf16x8, t_); }
#pragma unroll
        for (int tt = 0; tt < 4; ++tt) {
            f32x4 acc = {0.f, 0.f, 0.f, 0.f};
#pragma unroll
            for (int ks = 0; ks < 2; ++ks) { if (ks == 1 && tt < 2) continue;
                const bf16x8 am = *(const LAS bf16x8*)(AM + (16 * tt + c) * TS + 32 * ks + 8 * g);
                acc = __builtin_amdgcn_mfma_f32_16x16x32_bf16(vf[ks], am, acc, 0, 0, 0); }
            if (jj > 0) {
#pragma unroll
                for (int ks = 0; ks < 4; ++ks) { const v2u q0 = *(const LAS v2u*)(QEO + (16 * tt + c) * QEP + 32 * ks + 4 * g), q1 = *(const LAS v2u*)(QEO + (16 * tt + c) * QEP + 32 * ks + 16 + 4 * g);
                    const v4u qv = {q0.x, q0.y, q1.x, q1.y};
                    acc = __builtin_amdgcn_mfma_f32_16x16x32_bf16(lf[ks], __builtin_bit_cast(bf16x8, qv), acc, 0, 0, 0); } }
            *(LAS v2u*)(F.lds + HP_INO + (16 * tt + c) * 272 + (16 * w + 4 * g) * 2) = (v2u){pk2(acc[0], acc[1]), pk2(acc[2], acc[3])};
        }
#pragma unroll
        for (int dt = 0; dt < 8; ++dt) {
            f32x4 acc = {0.f, 0.f, 0.f, 0.f};
#pragma unroll
            for (int ks = 0; ks < 2; ++ks) {
                const bf16x8 kd = *(const LAS bf16x8*)(KDT + (16 * dt + c) * TS + 32 * ks + 8 * g);
                acc = __builtin_amdgcn_mfma_f32_16x16x32_bf16(kd, vf[ks], acc, 0, 0, 0); }
            const f32x4 dl = *(const LAS f32x4*)(DLT + 16 * dt + 4 * g);
            Lst[dt] = dl * Lst[dt] + acc;
        }
        __syncthreads();
#pragma unroll
        for (int j = 0; j < 2; ++j) { const v4u r_ = *(const LAS v4u*)(F.lds + HP_INO + (prow + 32 * j) * 272 + pch * 16);
            *(GAS v4u*)(F.PROJ + (m0 + prow + 32 * j) * LDP + C_GF + h * 128 + pch * 8) = r_; }
        { const f32x4 p0 = *(const LAS f32x4*)(PT + 8 * pch), p1 = *(const LAS f32x4*)(PT + 8 * pch + 4);
#pragma unroll
          for (int j = 0; j < 2; ++j) { const v4u r_ = *(const LAS v4u*)(QEO + (prow + 32 * j) * QEP + pch * 8);
            v4u o_; o_.x = pk2(bflo(r_.x) * p0.x, bfhi(r_.x) * p0.y); o_.y = pk2(bflo(r_.y) * p0.z, bfhi(r_.y) * p0.w); o_.z = pk2(bflo(r_.z) * p1.x, bfhi(r_.z) * p1.y); o_.w = pk2(bflo(r_.w) * p1.z, bfhi(r_.w) * p1.w);
            *(GAS v4u*)(F.PROJ + (m0 + prow + 32 * j) * LDP + C_GQ + h * 128 + pch * 8) = o_; } }
    }
    __syncthreads();
    { const int grp = bh_ * 8 + u_;
      LAS unsigned char* slab = F.lds + HP_UTS + w * (16 * 272);
#pragma unroll
      for (int dt = 0; dt < 8; ++dt) *(LAS v2u*)(slab + c * 272 + (16 * dt + 4 * g) * 2) = (v2u){pk2(Lst[dt][0], Lst[dt][1]), pk2(Lst[dt][2], Lst[dt][3])};
      LDS_WAIT();
#pragma unroll
      for (int j = 0; j < 4; ++j) { const int p_ = lane + 64 * j, row_ = p_ >> 4, ch_ = p_ & 15;
          *(GAS v4u*)(F.UT + ((size_t)grp * 128 + 16 * w + row_) * 128 + ch_ * 8) = *(const LAS v4u*)(slab + row_ * 272 + ch_ * 16); }
      if (w == 0) *(GAS f32x2_t*)(F.DL + (size_t)grp * 128 + 2 * lane) = (f32x2_t){Pg[0], Pg[1]}; }
    __syncthreads();
#undef HP_LOADS
}

constexpr int HO_TSZ = 64 * 272, HO_QE = 0, HO_IN = HO_TSZ, HO_GZ = 2 * HO_TSZ, HO_OUT = 3 * HO_TSZ, HO_SSQ = 4 * HO_TSZ;
constexpr int HO_C0 = 8, HO_C1 = 6, HO_CX = 3, HO_NX = 0;
static_assert(HO_C0 + HO_C1 + 6 * HO_CX + HO_NX == 32 && HO_NX <= 6, "item split");
__device__ __forceinline__ void hg_out_items(Frame& F, int bh, int first, int cnt) {
    const int b = bh >> 3, h = bh & 7, w = F.wave, lane = F.lane, tid = F.tid, c = lane & 15, g = lane >> 4, e0 = 16 * w;
    LAS float* SSQ = (LAS float*)(F.lds + HO_SSQ);
    const f32x4 og = *(const f32x4*)(F.hg_g + e0 + 4 * g);
    const int prow = tid >> 4, pch = tid & 15;
    const int pofs = prow * 272 + pch * 16;
#define HO_DECL(S) v4u qreg##S[2], ireg##S[2], zreg##S[2];
#define HO_LOADS(S, k) do { const size_t m0_ = (size_t)b * SEQ + (size_t)(first + (k)) * CHUNK; \
        _Pragma("unroll") for (int j = 0; j < 2; ++j) { const bf16* rp_ = F.PROJ + (m0_ + prow + 32 * j) * LDP + h * 128 + pch * 8; \
            qreg##S[j] = *(const GAS v4u*)(rp_ + C_GQ); ireg##S[j] = *(const GAS v4u*)(rp_ + C_GF); zreg##S[j] = *(const GAS v4u*)(rp_ + C_GZ); } } while (0)
#define HO_COPYOUT(k) do { const size_t mo_ = (size_t)b * SEQ + (size_t)(first + (k)) * CHUNK; \
        _Pragma("unroll") for (int j = 0; j < 2; ++j) *(GAS v4u*)(F.MIX + (mo_ + prow + 32 * j) * DM + 1024 + h * 128 + pch * 8) = *(const LAS v4u*)(F.lds + HO_OUT + pofs + j * 32 * 272); } while (0)
#define HO_STEP(S, k) do { if ((k) < cnt) { \
        const int buf = (k) & 1; \
        _Pragma("unroll") for (int j = 0; j < 2; ++j) { *(LAS v4u*)(F.lds + HO_QE + pofs + j * 32 * 272) = qreg##S[j]; *(LAS v4u*)(F.lds + HO_IN + pofs + j * 32 * 272) = ireg##S[j]; \
            *(LAS v4u*)(F.lds + HO_GZ + pofs + j * 32 * 272) = zreg##S[j]; } \
        if ((((first + (k)) >> 2) != gcur)) { HO_ADV(); HO_PACK(); } \
        if ((k) + 3 < cnt) HO_LOADS(S, (k) + 3); \
        __syncthreads(); \
        if ((k) > 0) HO_COPYOUT((k) - 1); \
        f32x4 o[4]; v2u cgw[4]; \
        _Pragma("unroll") for (int mt = 0; mt < 4; ++mt) { \
            f32x4 acc = {0.f, 0.f, 0.f, 0.f}; \
            _Pragma("unroll") for (int ks = 0; ks < 4; ++ks) { const bf16x8 qf = *(const LAS bf16x8*)(F.lds + HO_QE + (16 * mt + c) * 272 + (32 * ks + 8 * g) * 2); \
                acc = __builtin_amdgcn_mfma_f32_16x16x32_bf16(csf[ks], qf, acc, 0, 0, 0); } \
            const v2u ciw = *(const LAS v2u*)(F.lds + HO_IN + (16 * mt + c) * 272 + (e0 + 4 * g) * 2); \
            cgw[mt] = *(const LAS v2u*)(F.lds + HO_GZ + (16 * mt + c) * 272 + (e0 + 4 * g) * 2); \
            acc[0] += bflo(ciw.x); acc[1] += bfhi(ciw.x); acc[2] += bflo(ciw.y); acc[3] += bfhi(ciw.y); \
            o[mt] = acc; \
            float ss = (acc[0] * acc[0] + acc[1] * acc[1]) + (acc[2] * acc[2] + acc[3] * acc[3]); \
            ss += __shfl_xor(ss, 16); ss += __shfl_xor(ss, 32); \
            if (g == 0) SSQ[buf * 512 + w * 64 + 16 * mt + c] = ss; } \
        __syncthreads(); \
        _Pragma("unroll") for (int mt = 0; mt < 4; ++mt) { \
            float tot = 0.f; \
            _Pragma("unroll") for (int ww = 0; ww < 8; ++ww) tot += SSQ[buf * 512 + ww * 64 + 16 * mt + c]; \
            const float rinv = __builtin_amdgcn_rsqf(tot * (1.f / 128.f) + EPS); \
            const f32x4 v = o[mt] * rinv * og; \
            *(LAS v2u*)(F.lds + HO_OUT + (16 * mt + c) * 272 + (e0 + 4 * g) * 2) = (v2u){pk2(v[0] * bflo(cgw[mt].x), v[1] * bfhi(cgw[mt].x)), pk2(v[2] * bflo(cgw[mt].y), v[3] * bfhi(cgw[mt].y))}; } \
    } } while (0)
    if (cnt <= 0) return;
    float Sg[4][8]; int gcur = 0; bf16x8 csf[4];
#pragma unroll
    for (int ks = 0; ks < 4; ++ks)
#pragma unroll
        for (int j = 0; j < 8; ++j) Sg[ks][j] = 0.f;
#define HO_GLOAD(U, D, grp_) do { const size_t gi_ = (size_t)(bh * 8 + (grp_)); \
        _Pragma("unroll") for (int ks = 0; ks < 4; ++ks) { U[ks] = *(const GAS v4u*)(F.UT + (gi_ * 128 + e0 + c) * 128 + 32 * ks + 8 * g); \
            D[2 * ks] = *(const GAS f32x4*)(F.DL + gi_ * 128 + 32 * ks + 8 * g); D[2 * ks + 1] = *(const GAS f32x4*)(F.DL + gi_ * 128 + 32 * ks + 8 * g + 4); } } while (0)
#define HO_GAPPLY(U, D) do { _Pragma("unroll") for (int ks = 0; ks < 4; ++ks) { \
        Sg[ks][0] = D[2 * ks].x * Sg[ks][0] + bflo(U[ks].x); Sg[ks][1] = D[2 * ks].y * Sg[ks][1] + bfhi(U[ks].x); Sg[ks][2] = D[2 * ks].z * Sg[ks][2] + bflo(U[ks].y); Sg[ks][3] = D[2 * ks].w * Sg[ks][3] + bfhi(U[ks].y); \
        Sg[ks][4] = D[2 * ks + 1].x * Sg[ks][4] + bflo(U[ks].z); Sg[ks][5] = D[2 * ks + 1].y * Sg[ks][5] + bfhi(U[ks].z); Sg[ks][6] = D[2 * ks + 1].z * Sg[ks][6] + bflo(U[ks].w); Sg[ks][7] = D[2 * ks + 1].w * Sg[ks][7] + bfhi(U[ks].w); } } while (0)
#define HO_ADV() do { v4u u_[4]; f32x4 d_[8]; HO_GLOAD(u_, d_, gcur); HO_GAPPLY(u_, d_); ++gcur; } while (0)
#define HO_PACK() do { _Pragma("unroll") for (int ks = 0; ks < 4; ++ks) { v4u t_; t_.x = pk2(Sg[ks][0], Sg[ks][1]); t_.y = pk2(Sg[ks][2], Sg[ks][3]); t_.z = pk2(Sg[ks][4], Sg[ks][5]); t_.w = pk2(Sg[ks][6], Sg[ks][7]); \
        csf[ks] = __builtin_bit_cast(bf16x8, t_); } } while (0)
    { const int g0 = first >> 2;
      int gq = 0;
      for (; gq + 1 < g0; gq += 2) { v4u ua[4], ub[4]; f32x4 da[8], db[8]; HO_GLOAD(ua, da, gq); HO_GLOAD(ub, db, gq + 1); HO_GAPPLY(ua, da); HO_GAPPLY(ub, db); }
      if (gq < g0) { v4u ua[4]; f32x4 da[8]; HO_GLOAD(ua, da, gq); HO_GAPPLY(ua, da); }
      gcur = g0; }
    HO_PACK();
    HO_DECL(A) HO_DECL(B) HO_DECL(C)
    HO_LOADS(A, 0); if (cnt > 1) HO_LOADS(B, 1); if (cnt > 2) HO_LOADS(C, 2);
#pragma unroll 1
    for (int k0 = 0; k0 < cnt; k0 += 3) { HO_STEP(A, k0); HO_STEP(B, k0 + 1); HO_STEP(C, k0 + 2); }
    __syncthreads();
    HO_COPYOUT(cnt - 1);
#undef HO_GLOAD
#undef HO_GAPPLY
#undef HO_ADV
#undef HO_PACK
#undef HO_DECL
#undef HO_LOADS
#undef HO_COPYOUT
#undef HO_STEP
}

namespace att {
constexpr int SHM_V = 16384, SHM_K = 16384, A_WS = 2 * SHM_V + 2 * SHM_K, A_BIAS = A_WS + NWAVES * 64 * 4, A_END = A_BIAS + 1040;
constexpr float THR2 = 8.0f * LOG2E;
#define KSWZ(row, colB) ((row) * 256 + ((colB) ^ (((row) & 7) << 4)))
#define SBAR() __builtin_amdgcn_sched_barrier(0)
__device__ __forceinline__ int crow(int r, int hi) { return (r & 3) + 8 * (r >> 2) + 4 * hi; }
__device__ __forceinline__ unsigned cvtpk(float lo, float hi) { unsigned r; asm volatile("v_cvt_pk_bf16_f32 %0, %1, %2" : "=v"(r) : "v"(lo), "v"(hi)); return r; }
__device__ __forceinline__ void partialSM(f32x16& p0, f32x16& p1, float& m_reg, float& alpha) {
  float pmax = p0[0];
#pragma unroll
  for (int r = 1; r < 16; ++r) pmax = fmaxf(pmax, p0[r]);
#pragma unroll
  for (int r = 0; r < 16; ++r) pmax = fmaxf(pmax, p1[r]);
  { auto rr = __builtin_amdgcn_permlane32_swap(__float_as_uint(pmax), __float_as_uint(pmax), false, false);
    pmax = fmaxf(__uint_as_float(rr[0]), __uint_as_float(rr[1])); }
  float mn;
  if (__builtin_expect(__all(pmax - m_reg <= THR2), 1)) { mn = m_reg; alpha = 1.f; }
  else { mn = fmaxf(m_reg, pmax); alpha = __builtin_amdgcn_exp2f(m_reg - mn); m_reg = mn; }
#pragma unroll
  for (int r = 0; r < 16; ++r) p0[r] = __builtin_amdgcn_exp2f(p0[r] - mn);
#pragma unroll
  for (int r = 0; r < 16; ++r) p1[r] = __builtin_amdgcn_exp2f(p1[r] - mn);
}
__device__ __forceinline__ void finishSM(f32x16& p0, f32x16& p1, float alpha, float& l_reg, bf16x8& pa0, bf16x8& pa1, bf16x8& pa2, bf16x8& pa3) {
  float ps = 0;
#pragma unroll
  for (int r = 0; r < 16; ++r) ps += p0[r];
#pragma unroll
  for (int r = 0; r < 16; ++r) ps += p1[r];
  { auto rr = __builtin_amdgcn_permlane32_swap(__float_as_uint(ps), __float_as_uint(ps), false, false);
    ps = __uint_as_float(rr[0]) + __uint_as_float(rr[1]); }
  l_reg = l_reg * alpha + ps;
#define PK4(P, BASE, OUT) do { unsigned a0 = cvtpk(P[BASE + 0], P[BASE + 1]), a1 = cvtpk(P[BASE + 2], P[BASE + 3]);   \
    unsigned b0 = cvtpk(P[BASE + 4], P[BASE + 5]), b1 = cvtpk(P[BASE + 6], P[BASE + 7]);                              \
    auto r0 = __builtin_amdgcn_permlane32_swap(a0, b0, false, false); auto r1 = __builtin_amdgcn_permlane32_swap(a1, b1, false, false); \
    v4u w_ = {r0[0], r1[0], r0[1], r1[1]}; OUT = __builtin_bit_cast(bf16x8, w_); } while (0)
  PK4(p0, 0, pa0); PK4(p0, 8, pa1); PK4(p1, 0, pa2); PK4(p1, 8, pa3);
#undef PK4
}
__device__ __forceinline__ void qkt(f32x16& p0, f32x16& p1, const LAS char* Ks, const bf16x8* qr, int r32, int hi) {
  p0 = f32x16{}; p1 = f32x16{};
#pragma unroll
  for (int d0 = 0; d0 < 8; ++d0) { const int cb = (d0 * 16 + hi * 8) * 2;
    const bf16x8 b0 = *(const LAS bf16x8*)(Ks + KSWZ(r32, cb));
    const bf16x8 b1 = *(const LAS bf16x8*)(Ks + KSWZ(32 + r32, cb));
    p0 = __builtin_amdgcn_mfma_f32_32x32x16_bf16(b0, qr[d0], p0, 0, 0, 0);
    p1 = __builtin_amdgcn_mfma_f32_32x32x16_bf16(b1, qr[d0], p1, 0, 0, 0); }
}
__device__ __forceinline__ int v_st(int k, int c) { const int kk = (k & ~0xC) | ((k & 4) << 1) | ((k & 8) >> 1); return ((kk >> 3) * 4 + (c >> 5)) * 512 + ((kk & 7) * 32 + (c & 31)) * 2; }
__device__ __forceinline__ int v_rd_base(int lane) { return ((lane & 3) << 3) | (((lane >> 2) & 3) << 6) | (((lane >> 4) & 1) << 5) | (((lane >> 5) & 1) << 8); }
constexpr int v_rd_off(int d0, int ks, int half) { return d0 * 512 + ks * 4096 + half * 2048; }
template <int OFF> __device__ __forceinline__ s16x4 tr_read(int vb) {
  s16x4 r; asm volatile("ds_read_b64_tr_b16 %0, %1 offset:%2" : "=&v"(r) : "v"(vb), "i"(OFF) : "memory"); return r;
}
template <int D0> __device__ __forceinline__ void pv_one(f32x16& od, int vb, bf16x8 pa0, bf16x8 pa1, bf16x8 pa2, bf16x8 pa3) {
  const s16x4 l0 = tr_read<v_rd_off(D0, 0, 0)>(vb), h0 = tr_read<v_rd_off(D0, 0, 1)>(vb), l1 = tr_read<v_rd_off(D0, 1, 0)>(vb), h1 = tr_read<v_rd_off(D0, 1, 1)>(vb);
  const s16x4 l2 = tr_read<v_rd_off(D0, 2, 0)>(vb), h2 = tr_read<v_rd_off(D0, 2, 1)>(vb), l3 = tr_read<v_rd_off(D0, 3, 0)>(vb), h3 = tr_read<v_rd_off(D0, 3, 1)>(vb);
  asm volatile("s_waitcnt lgkmcnt(0)" ::: "memory"); SBAR();
#define PK(L, H) (bf16x8){L[0], L[1], L[2], L[3], H[0], H[1], H[2], H[3]}
  od = __builtin_amdgcn_mfma_f32_32x32x16_bf16(pa0, PK(l0, h0), od, 0, 0, 0);
  od = __builtin_amdgcn_mfma_f32_32x32x16_bf16(pa1, PK(l1, h1), od, 0, 0, 0);
  od = __builtin_amdgcn_mfma_f32_32x32x16_bf16(pa2, PK(l2, h2), od, 0, 0, 0);
  od = __builtin_amdgcn_mfma_f32_32x32x16_bf16(pa3, PK(l3, h3), od, 0, 0, 0);
#undef PK
}
__device__ __forceinline__ void pv_d0(f32x16* o, int vb, bf16x8 pa0, bf16x8 pa1, bf16x8 pa2, bf16x8 pa3) {
  pv_one<0>(o[0], vb, pa0, pa1, pa2, pa3); pv_one<1>(o[1], vb, pa0, pa1, pa2, pa3); pv_one<2>(o[2], vb, pa0, pa1, pa2, pa3); pv_one<3>(o[3], vb, pa0, pa1, pa2, pa3);
}

__device__ __forceinline__ void attn_unit(int b, int h, int u, const bf16* PROJ, bf16* MIX, const float* rel_bias, const float* q_g, const float* k_g, LAS unsigned char* lds) {
  const int tid = threadIdx.x, lane = tid & 63, r32 = lane & 31, hi = lane >> 5; const int wid = __builtin_amdgcn_readfirstlane(tid >> 6);
  LAS char* V_lds = (LAS char*)lds; LAS char* K_lds = (LAS char*)lds + 2 * SHM_V;
  LAS float* ws = (LAS float*)(lds + A_WS) + wid * 64; LAS float* li_l = ws; LAS float* al_l = ws + 32;
  LAS float* bl = (LAS float*)(lds + A_BIAS);
  if (tid < 257) { const float far = rel_bias[h * 257 + 256]; bl[tid] = (rel_bias[h * 257 + tid] - far) * LOG2E; }
  float m_reg = -1e30f, l_reg = 0; f32x16 o[4] = {}; bf16x8 qr[8];
  const size_t mrow0 = (size_t)b * SEQ + 256 * u;
  const bf16* Qw = PROJ + (mrow0 + wid * 32 + r32) * LDP + C_AQ + h * 128 + hi * 8;
  {
    v4u qw[8]; float ss = 0.f;
#pragma unroll
    for (int d0 = 0; d0 < 8; ++d0) { qw[d0] = *(const GAS v4u*)(Qw + d0 * 16);
      const float a0 = bflo(qw[d0].x), a1 = bfhi(qw[d0].x), a2 = bflo(qw[d0].y), a3 = bfhi(qw[d0].y), a4 = bflo(qw[d0].z), a5 = bfhi(qw[d0].z), a6 = bflo(qw[d0].w), a7 = bfhi(qw[d0].w);
      ss += (a0 * a0 + a1 * a1) + (a2 * a2 + a3 * a3) + (a4 * a4 + a5 * a5) + (a6 * a6 + a7 * a7); }
    { auto rr = __builtin_amdgcn_permlane32_swap(__float_as_uint(ss), __float_as_uint(ss), false, false); ss = __uint_as_float(rr[0]) + __uint_as_float(rr[1]); }
    const float rq = __builtin_amdgcn_rsqf(ss * (1.f / DH) + EPS) * (0.08838834764831845f * LOG2E);
#pragma unroll
    for (int d0 = 0; d0 < 8; ++d0) { const f32x4 g0 = *(const f32x4*)(q_g + d0 * 16 + hi * 8), g1 = *(const f32x4*)(q_g + d0 * 16 + hi * 8 + 4);
      v4u o_; o_.x = pk2(bflo(qw[d0].x) * rq * g0.x, bfhi(qw[d0].x) * rq * g0.y); o_.y = pk2(bflo(qw[d0].y) * rq * g0.z, bfhi(qw[d0].y) * rq * g0.w);
      o_.z = pk2(bflo(qw[d0].z) * rq * g1.x, bfhi(qw[d0].z) * rq * g1.y); o_.w = pk2(bflo(qw[d0].w) * rq * g1.z, bfhi(qw[d0].w) * rq * g1.w);
      qr[d0] = __builtin_bit_cast(bf16x8, o_); } }
  const bf16* Kh = PROJ + (size_t)b * SEQ * LDP + C_AK + h * 128; const bf16* Vh = PROJ + (size_t)b * SEQ * LDP + C_AV + h * 128;
  const int sr = tid >> 4, sc = (tid & 15) * 8, vst0 = v_st(sr, sc), vst1 = v_st(32 + sr, sc);
  const int vb0 = (int)(uintptr_t)V_lds + v_rd_base(lane);
  const int cw = 4 * u + (wid >> 1), kc_lo = (4 * u - 8 > 0) ? 4 * u - 8 : 0, NT = 4 * u + 3 - kc_lo + 1;
  const int qloc = 32 * (wid & 1) + r32;
  bf16x8 vs0, vs1, ks0, ks1;
  const f32x4 kg0 = *(const f32x4*)(k_g + sc), kg1 = *(const f32x4*)(k_g + sc + 4);
#define SLOAD(k0) do { vs0 = *(const GAS bf16x8*)(Vh + (size_t)((k0) + sr) * LDP + sc); vs1 = *(const GAS bf16x8*)(Vh + (size_t)((k0) + 32 + sr) * LDP + sc); \
    ks0 = *(const GAS bf16x8*)(Kh + (size_t)((k0) + sr) * LDP + sc); ks1 = *(const GAS bf16x8*)(Kh + (size_t)((k0) + 32 + sr) * LDP + sc); } while (0)
#define KNORM(kx) do { const v4u w_ = __builtin_bit_cast(v4u, kx); \
    const float a0 = bflo(w_.x), a1 = bfhi(w_.x), a2 = bflo(w_.y), a3 = bfhi(w_.y), a4 = bflo(w_.z), a5 = bfhi(w_.z), a6 = bflo(w_.w), a7 = bfhi(w_.w); \
    float ss_ = (a0 * a0 + a1 * a1) + (a2 * a2 + a3 * a3) + (a4 * a4 + a5 * a5) + (a6 * a6 + a7 * a7); \
    ss_ += __shfl_xor(ss_, 1); ss_ += __shfl_xor(ss_, 2); ss_ += __shfl_xor(ss_, 4); ss_ += __shfl_xor(ss_, 8); \
    const float rk_ = __builtin_amdgcn_rsqf(ss_ * (1.f / DH) + EPS); \
    v4u o_; o_.x = pk2(a0 * rk_ * kg0.x, a1 * rk_ * kg0.y); o_.y = pk2(a2 * rk_ * kg0.z, a3 * rk_ * kg0.w); o_.z = pk2(a4 * rk_ * kg1.x, a5 * rk_ * kg1.y); o_.w = pk2(a6 * rk_ * kg1.z, a7 * rk_ * kg1.w); \
    kx = __builtin_bit_cast(bf16x8, o_); } while (0)
#define SWRITE(bb) do { *(LAS bf16x8*)(V_lds + (bb) * SHM_V + vst0) = vs0; *(LAS bf16x8*)(V_lds + (bb) * SHM_V + vst1) = vs1; const int kc_ = sc * 2; \
    KNORM(ks0); KNORM(ks1); \
    *(LAS bf16x8*)(K_lds + (bb) * SHM_K + KSWZ(sr, kc_)) = ks0; *(LAS bf16x8*)(K_lds + (bb) * SHM_K + KSWZ(32 + sr, kc_)) = ks1; } while (0)
  SLOAD(kc_lo * 64); SWRITE(0); __syncthreads();
  for (int j = 0; j < NT; ++j) {
    const int kc = kc_lo + j, buf = j & 1;
    if (j + 1 < NT) SLOAD((kc + 1) * 64);
    if (kc >= cw - 8 && kc <= cw) {
      f32x16 p0, p1; float alpha; bf16x8 pa0, pa1, pa2, pa3;
      qkt(p0, p1, K_lds + buf * SHM_K, qr, r32, hi);
      const int delta = cw - kc;
      if (delta <= 2) {
        const int base = delta * 64 + qloc + 128;
#pragma unroll
        for (int r = 0; r < 16; ++r) { const int i0 = base - crow(r, hi), i1 = i0 - 32;
          p0[r] += bl[i0 > 256 ? 256 : i0]; p1[r] += bl[i1 > 256 ? 256 : i1]; }
      }
      partialSM(p0, p1, m_reg, alpha);
      if (__any(alpha < 1.f)) { if (hi == 0) al_l[r32] = alpha; asm volatile("s_waitcnt lgkmcnt(0)" ::: "memory");
#pragma unroll
        for (int d = 0; d < 4; ++d)
#pragma unroll
          for (int r = 0; r < 16; ++r) o[d][r] *= al_l[crow(r, hi)]; }
      finishSM(p0, p1, alpha, l_reg, pa0, pa1, pa2, pa3); SBAR();
      pv_d0(o, vb0 + buf * SHM_V, pa0, pa1, pa2, pa3);
    }
    if (j + 1 < NT) SWRITE(buf ^ 1);
    __syncthreads();
  }
#undef SLOAD
#undef SWRITE
#undef KNORM
  if (hi == 0) li_l[r32] = l_reg; asm volatile("s_waitcnt lgkmcnt(0)" ::: "memory");
  float rli[16];
#pragma unroll
  for (int r = 0; r < 16; ++r) rli[r] = __builtin_amdgcn_rcpf(li_l[crow(r, hi)]);
#pragma unroll
  for (int r = 0; r < 16; ++r) { const size_t row = mrow0 + wid * 32 + crow(r, hi);
#pragma unroll
    for (int d0 = 0; d0 < 4; ++d0) { const float gz = bf2f(PROJ[row * LDP + C_AZ + h * 128 + d0 * 32 + r32]);
      MIX[row * DM + h * 128 + d0 * 32 + r32] = (bf16)f2bf(o[d0][r] * rli[r] * gz); } }
  __syncthreads();
}
#undef KSWZ
#undef SBAR
}

struct Args { const float* in[12]; float* out; unsigned char* ws; };
__global__ void __launch_bounds__(NWAVES * 64, 2) hymba_fwd(Args args) {
    extern __shared__ __attribute__((aligned(16))) unsigned char lds[];
    Frame F;
    F.lds = (LAS unsigned char*)lds;
    F.MISC = (volatile LAS unsigned*)(F.lds + MISC_OFF);
    F.tid = threadIdx.x; F.lane = F.tid & 63; F.wave = __builtin_amdgcn_readfirstlane(F.tid >> 6);
    F.G = gridDim.x; { const int bx = blockIdx.x; F.vcu = (bx % 8) * (F.G / 8) + bx / 8; }
    unsigned char* ws = args.ws;
    F.ctl = (gu32*)(ws + WS_CTL);
    F.x = args.in[0]; F.c = args.in[1]; F.norm_g = args.in[2]; F.w_ada = args.in[3]; F.b_ada = args.in[4]; F.w_in = args.in[5];
    F.q_g = args.in[6]; F.k_g = args.in[7]; F.rel_bias = args.in[8]; F.lower_bounds = args.in[9]; F.hg_g = args.in[10]; F.w_out = args.in[11];
    F.out = args.out; F.mod = (float*)(ws + WS_CTL) + CW_MOD;
    F.WIN = (bf16*)(ws + WS_WIN); F.WOUT = (bf16*)(ws + WS_WOUT); F.HB = (bf16*)(ws + WS_H); F.MIX = (bf16*)(ws + WS_MIX);
    F.PROJ = (bf16*)(ws + WS_PROJ); F.UT = (bf16*)(ws + WS_UT); F.DL = (float*)(ws + WS_DL);
    for (int u = F.tid; u < (LDS_BYTES - LDSCTL_OFF) / 4; u += NWAVES * 64) ((LAS unsigned*)(F.lds + LDSCTL_OFF))[u] = 0u;
    __syncthreads();
    const XcdBarrier bar = xcd_barrier_post((unsigned*)(F.ctl + CW_BAR), F.MISC + 8);
#define GRID_BAR() xcd_barrier(bar)

    p0_prologue(F);
    GRID_BAR();
    p1_rows(F);
    GRID_BAR();
    { pg8::Gemm g{F.HB, F.WIN, MROWS, NIN, DM}; pg8::StaticOrder S; S.init(MROWS, NIN, F.G, (int)blockIdx.x);
      pg8::EpiProj E{F.PROJ, LDP};
      pg8::gemm_phase<pg8::EpiProj, pg8::StaticOrder, true, true>(F.lds + RING_OFF, g, S, E); }
    GRID_BAR();
    const int bh = F.vcu >> 3, u = F.vcu & 7;
    hg_prep_items(F);
    GRID_BAR();
    { const int ur = 7 - u;
      const int cnt = (u == 0) ? HO_C0 : (u == 1) ? HO_C1 : (ur < HO_NX) ? HO_CX + 1 : HO_CX;
      const int first = (u >= 2) ? HO_CX * ur + ((ur < HO_NX) ? ur : HO_NX) : (u == 1) ? 6 * HO_CX + HO_NX : 6 * HO_CX + HO_NX + HO_C1;
      const bool attn_first = (bh & 1) != 0;
      if (!attn_first) { hg_out_items(F, bh, first, cnt); __syncthreads(); }
      att::attn_unit(bh >> 3, bh & 7, u, F.PROJ, F.MIX, F.rel_bias, F.q_g, F.k_g, F.lds);
      if (attn_first) { hg_out_items(F, bh, first, cnt); __syncthreads(); } }
    GRID_BAR();
    { pg8::Gemm g{F.MIX, F.WOUT, MROWS, DM, DM}; pg8::StaticOrder S; S.init(MROWS, DM, F.G, (int)blockIdx.x);
      pg8::EpiOut E{F.x, F.out, F.mod + 2 * DM};
      pg8::gemm_phase<pg8::EpiOut, pg8::StaticOrder, true, true>(F.lds + RING_OFF, g, S, E); }
#undef GRID_BAR
}

extern "C" void kernel_launch(void* const* d_in, const int* in_sizes, int n_in, void* d_out, int out_size, void* d_ws, size_t ws_size, hipStream_t stream) {
    static int grid = 0;
    if (grid == 0) {
        if (n_in != 12 || in_sizes[0] != MROWS * DM || out_size != MROWS * DM || ws_size < WS_END) {
            fprintf(stderr, "kernel_launch: shape mismatch: n_in %d in0 %d out %d ws %zu (need %zu)\n", n_in, n_in > 0 ? in_sizes[0] : -1, out_size, ws_size, (size_t)WS_END); grid = -1; return; }
        int dev = 0, cus = 0, per_cu = 0;
        if (hipGetDevice(&dev) != hipSuccess || hipDeviceGetAttribute(&cus, hipDeviceAttributeMultiprocessorCount, dev) != hipSuccess) { fprintf(stderr, "kernel_launch: device query failed\n"); grid = -1; return; }
        if (hipFuncSetAttribute((const void*)hymba_fwd, hipFuncAttributeMaxDynamicSharedMemorySize, LDS_BYTES) != hipSuccess) { fprintf(stderr, "kernel_launch: hipFuncSetAttribute failed\n"); grid = -1; return; }
        if (hipOccupancyMaxActiveBlocksPerMultiprocessor(&per_cu, (const void*)hymba_fwd, NWAVES * 64, LDS_BYTES) != hipSuccess || per_cu < 1) {
            fprintf(stderr, "kernel_launch: occupancy query reports %d workgroups per CU; not launching\n", per_cu); (void)hipGetLastError(); grid = -1; return; }
        grid = cus;
        if (grid != 256) { fprintf(stderr, "kernel_launch: built for a 256-CU device (got %d); not launching\n", grid); grid = -1; return; }
    }
    if (grid <= 0) return;
    if (hipMemsetAsync((char*)d_ws + WS_CTL, 0, CTL_ZERO_BYTES, stream) != hipSuccess) { fprintf(stderr, "kernel_launch: memset failed\n"); return; }
    Args a{};
    for (int i = 0; i < 12; ++i) a.in[i] = (const float*)d_in[i];
    a.out = (float*)d_out; a.ws = (unsigned char*)d_ws;
    void* kargs[] = {&a};
    const hipError_t e = hipLaunchCooperativeKernel((const void*)hymba_fwd, dim3(grid), dim3(NWAVES * 64), kargs, LDS_BYTES, stream);
    if (e != hipSuccess) fprintf(stderr, "kernel_launch: cooperative launch failed: %s (grid %d)\n", hipGetErrorString(e), grid);
}
```
